# Optimizing an MI355X kernel written in HIP

```python
import math
import jax, jax.numpy as jnp
from jax import lax
import numpy as np

D_MODEL = 1024
BATCH = 16
SEQ = 2048
DEPTH = 2

GRID_W = 64
CTX_LEN = 256
EPS = 1e-6

HEAD_DIM = 64
NA_WIDTH = D_MODEL // 2
NA_HEADS = NA_WIDTH // HEAD_DIM
NA_WIN_H = 8
NA_WIN_W = 16
S5_WIDTH = D_MODEL // 4
S5_GROUP = 16
S5_GROUPS = S5_WIDTH // S5_GROUP
S5_STATE = 64
S5_DT_MIN = 0.001
S5_DT_MAX = 0.1
FNET_WIDTH = D_MODEL // 4
FNET_HEAD_DIM = 64
FNET_HEADS = FNET_WIDTH // FNET_HEAD_DIM
MIX_WIDTH = NA_WIDTH + S5_WIDTH + FNET_WIDTH
IN_COLS = 3 * NA_WIDTH + S5_WIDTH + FNET_WIDTH
IN_SPLITS = (NA_WIDTH, 2 * NA_WIDTH, 3 * NA_WIDTH, 3 * NA_WIDTH + S5_WIDTH)
ATTN_SCALE = HEAD_DIM ** -0.5
ROPE_BASE = 100.0
ROPE_PAIRS_PER_AXIS = HEAD_DIM // 4

N_EXPERTS = 16
N_EXPERT_GROUPS = 4
EXPERTS_PER_GROUP = N_EXPERTS // N_EXPERT_GROUPS
TOP_K = 2
EXPERT_FF = 512

kernel_name = "hybrid_na_s5_fnet_moe_dit"


def rms_norm(x, g):
    xf = x.astype(jnp.float32)
    y = xf * lax.rsqrt(jnp.mean(xf * xf, axis=-1, keepdims=True) + EPS)
    return (y * g.astype(jnp.float32)).astype(x.dtype)


def axial_rope(n_tokens):
    t = jnp.arange(n_tokens, dtype=jnp.int32)
    row = (t // GRID_W).astype(jnp.float32)
    col = (t % GRID_W).astype(jnp.float32)
    inv_freq = ROPE_BASE ** (-jnp.arange(ROPE_PAIRS_PER_AXIS, dtype=jnp.float32) / ROPE_PAIRS_PER_AXIS)
    ang = jnp.concatenate([row[:, None] * inv_freq, col[:, None] * inv_freq], axis=-1)
    return jnp.cos(ang), jnp.sin(ang)


def apply_rope(x, cos, sin):
    half = HEAD_DIM // 2
    x1, x2 = x[..., :half], x[..., half:]
    cs = cos[:, None, :].astype(x.dtype)
    sn = sin[:, None, :].astype(x.dtype)
    return jnp.concatenate([x1 * cs - x2 * sn, x1 * sn + x2 * cs], axis=-1)


def neighbourhood_attention(q, k, v, k_ctx, v_ctx, rpb):
    B, L, H, dh = q.shape
    rows = L // GRID_W
    kh = min(NA_WIN_H, rows)
    kw = NA_WIN_W
    qg = jnp.moveaxis(q.reshape(B, rows, GRID_W, H, dh), 1, 0)
    kg = k.reshape(B, rows, GRID_W, H, dh)
    vg = v.reshape(B, rows, GRID_W, H, dh)
    col = jnp.arange(GRID_W, dtype=jnp.int32)
    col_start = jnp.clip(col - kw // 2, 0, GRID_W - kw)
    col_idx = col_start[:, None] + jnp.arange(kw, dtype=jnp.int32)[None, :]
    col_off = col_idx - col[:, None] + (NA_WIN_W - 1)

    def row_block(args):
        r, q_r = args
        row_start = jnp.clip(r - kh // 2, 0, rows - kh)
        k_rows = lax.dynamic_slice_in_dim(kg, row_start, kh, axis=1)
        v_rows = lax.dynamic_slice_in_dim(vg, row_start, kh, axis=1)
        k_win = k_rows[:, :, col_idx]
        v_win = v_rows[:, :, col_idx]
        row_off = row_start + jnp.arange(kh, dtype=jnp.int32) - r + (NA_WIN_H - 1)
        bias = rpb[:, row_off][:, :, col_off]
        bias = jnp.transpose(bias, (0, 2, 1, 3)).reshape(H, GRID_W, kh * kw)
        s_loc = jnp.einsum('bchd,bicjhd->bhcij', q_r, k_win).reshape(B, H, GRID_W, kh * kw)
        s_loc = s_loc.astype(jnp.float32) * ATTN_SCALE + bias.astype(jnp.float32)
        s_ctx = jnp.einsum('bchd,bjhd->bhcj', q_r, k_ctx).astype(jnp.float32) * ATTN_SCALE
        p = jax.nn.softmax(jnp.concatenate([s_loc, s_ctx], axis=-1), axis=-1).astype(v.dtype)
        p_loc = p[..., :kh * kw].reshape(B, H, GRID_W, kh, kw)
        p_ctx = p[..., kh * kw:]
        return (jnp.einsum('bhcij,bicjhd->bchd', p_loc, v_win)
                + jnp.einsum('bhcj,bjhd->bchd', p_ctx, v_ctx))

    out = lax.map(row_block, (jnp.arange(rows, dtype=jnp.int32), qg))
    return jnp.moveaxis(out, 0, 1).reshape(B, L, H, dh)


def context_attention(qc, kc, vc):
    s = jnp.einsum('bqhd,bkhd->bhqk', qc, kc).astype(jnp.float32) * ATTN_SCALE
    p = jax.nn.softmax(s, axis=-1).astype(vc.dtype)
    return jnp.einsum('bhqk,bkhd->bqhd', p, vc)


def s5_discretise(lam_re, lam_im, log_step, b_re, b_im):
    lam = lax.complex(lam_re.astype(jnp.float32), lam_im.astype(jnp.float32))
    step = jnp.exp(log_step.astype(jnp.float32))[:, None]
    lam_bar = jnp.exp(lam * step)
    b = lax.complex(b_re.astype(jnp.float32), b_im.astype(jnp.float32))
    b_bar = ((lam_bar - 1.0) / lam)[..., None] * b
    return lam_bar, b_bar


def _linear_recurrence(left, right):
    a_l, b_l = left
    a_r, b_r = right
    return a_l * a_r, a_r * b_l + b_r


def s5_scan(u, lam_bar, b_bar, h0, reverse):
    bu = jnp.einsum('blgc,gpc->blgp', u.astype(jnp.complex64), b_bar)
    if reverse:
        bu = jnp.flip(bu, axis=1)
    if h0 is not None:
        bu = bu.at[:, 0].add(lam_bar * h0)
    a = jnp.broadcast_to(lam_bar, (1, bu.shape[1]) + lam_bar.shape)
    _, h = lax.associative_scan(_linear_recurrence, (a, bu), axis=1)
    return jnp.flip(h, axis=1) if reverse else h


def s5_glu(y, w_glu, b_glu):
    g = jax.nn.gelu(y)
    return g * jax.nn.sigmoid(g @ w_glu + b_glu)


def s5_mixer(u, u_ctx, lam_re, lam_im, log_step, b_re, b_im, c_re, c_im, d_skip, w_glu, b_glu, ctx_out):
    B, L, _ = u.shape
    Lc = u_ctx.shape[1]
    ug = u.astype(jnp.float32).reshape(B, L, S5_GROUPS, S5_GROUP)
    ucg = u_ctx.astype(jnp.float32).reshape(B, Lc, S5_GROUPS, S5_GROUP)
    d = d_skip.astype(jnp.float32).reshape(S5_GROUPS, S5_GROUP)
    y = d * ug
    yc = d * ucg if ctx_out else None
    for direction in range(2):
        rev = direction == 1
        lam_bar, b_bar = s5_discretise(lam_re[direction], lam_im[direction], log_step[direction],
                                       b_re[direction], b_im[direction])
        c_mat = lax.complex(c_re[direction].astype(jnp.float32), c_im[direction].astype(jnp.float32))
        h_ctx = s5_scan(ucg, lam_bar, b_bar, None, rev)
        h0 = h_ctx[:, 0] if rev else h_ctx[:, -1]
        h = s5_scan(ug, lam_bar, b_bar, h0, rev)
        y = y + jnp.einsum('blgp,gcp->blgc', h, c_mat).real
        if ctx_out:
            yc = yc + jnp.einsum('blgp,gcp->blgc', h_ctx, c_mat).real
    out = s5_glu(y.reshape(B, L, S5_WIDTH).astype(u.dtype), w_glu, b_glu)
    if not ctx_out:
        return out, None
    out_c = s5_glu(yc.reshape(B, Lc, S5_WIDTH).astype(u.dtype), w_glu, b_glu)
    return out, out_c


def fourier_mixer(u, w_fnet):
    f = jnp.fft.fft2(u.astype(jnp.float32), axes=(1, 3), norm='ortho').real.astype(u.dtype)
    return jnp.einsum('blhd,hde->blhe', f, w_fnet)


def token_mixers(h, hc, rope_cos, rope_sin, w_in, q_norm_g, k_norm_g, rpb,
                 lam_re, lam_im, log_step, b_re, b_im, c_re, c_im, d_skip,
                 w_glu, b_glu, w_fnet, w_out, ctx_out):
    B, L, _ = h.shape
    Lc = hc.shape[1]
    q, k, v, u_s5, u_f = jnp.split(h @ w_in, IN_SPLITS, axis=-1)
    q = apply_rope(rms_norm(q.reshape(B, L, NA_HEADS, HEAD_DIM), q_norm_g), rope_cos, rope_sin)
    k = apply_rope(rms_norm(k.reshape(B, L, NA_HEADS, HEAD_DIM), k_norm_g), rope_cos, rope_sin)
    v = v.reshape(B, L, NA_HEADS, HEAD_DIM)
    if ctx_out:
        qc, kc, vc, uc_s5, uc_f = jnp.split(hc @ w_in, IN_SPLITS, axis=-1)
    else:
        kc, vc, uc_s5 = jnp.split(hc @ w_in[:, NA_WIDTH:3 * NA_WIDTH + S5_WIDTH],
                                  (NA_WIDTH, 2 * NA_WIDTH), axis=-1)
    kc = rms_norm(kc.reshape(B, Lc, NA_HEADS, HEAD_DIM), k_norm_g)
    vc = vc.reshape(B, Lc, NA_HEADS, HEAD_DIM)

    att = neighbourhood_attention(q, k, v, kc, vc, rpb).reshape(B, L, NA_WIDTH)
    ssm, ssm_c = s5_mixer(u_s5, uc_s5, lam_re, lam_im, log_step, b_re, b_im, c_re, c_im, d_skip,
                          w_glu, b_glu, ctx_out)
    fou = fourier_mixer(u_f.reshape(B, L, FNET_HEADS, FNET_HEAD_DIM), w_fnet).reshape(B, L, FNET_WIDTH)
    out = jnp.concatenate([att, ssm, fou], axis=-1) @ w_out
    if not ctx_out:
        return out, None
    qc = rms_norm(qc.reshape(B, Lc, NA_HEADS, HEAD_DIM), q_norm_g)
    att_c = context_attention(qc, kc, vc).reshape(B, Lc, NA_WIDTH)
    fou_c = fourier_mixer(uc_f.reshape(B, Lc, FNET_HEADS, FNET_HEAD_DIM), w_fnet).reshape(B, Lc, FNET_WIDTH)
    out_c = jnp.concatenate([att_c, ssm_c, fou_c], axis=-1) @ w_out
    return out, out_c


def moe_ffn(t, w_router, b_router, w_gate, w_up, w_down):
    n_tok = t.shape[0]
    affinity = jax.nn.sigmoid((t @ w_router).astype(jnp.float32))
    select = (affinity + b_router.astype(jnp.float32)).reshape(n_tok, N_EXPERT_GROUPS, EXPERTS_PER_GROUP)
    group_score = jnp.sum(lax.top_k(select, TOP_K)[0], axis=-1)
    g_idx = jnp.argmax(group_score, axis=-1)
    in_group = jnp.take_along_axis(select, g_idx[:, None, None], axis=1)[:, 0]
    e_idx = g_idx[:, None] * EXPERTS_PER_GROUP + lax.top_k(in_group, TOP_K)[1]
    w = jnp.take_along_axis(affinity, e_idx, axis=-1)
    w = w / jnp.sum(w, axis=-1, keepdims=True)
    gates = jnp.sum(jax.nn.one_hot(e_idx, N_EXPERTS, dtype=jnp.float32) * w[..., None], axis=1).astype(t.dtype)
    y = jnp.zeros_like(t)
    for e in range(N_EXPERTS):
        he = jax.nn.silu(t @ w_gate[e]) * (t @ w_up[e])
        y = y + gates[:, e:e + 1] * (he @ w_down[e])
    return y


def setup_inputs(seed: int = 0) -> dict:
    key = jax.random.key(seed)
    ks = jax.random.split(key, 32)
    f32 = jnp.float32
    D = D_MODEL

    def nrm(k, shape, scale):
        return jax.random.normal(k, shape, f32) * scale

    s5_shape = (DEPTH, 2, S5_GROUPS, S5_STATE)
    return {
        "x": nrm(ks[0], (BATCH, SEQ, D), 1.0),
        "c": nrm(ks[1], (BATCH, D), 1.0),
        "ctx": nrm(ks[2], (BATCH, CTX_LEN, D), 1.0),
        "c_ctx": nrm(ks[3], (D,), 1.0),
        "w_ada": nrm(ks[4], (DEPTH, D, 6 * D), 0.5 * D ** -0.5),
        "b_ada": nrm(ks[5], (DEPTH, 6 * D), 0.01),
        "norm1_g": 1.0 + nrm(ks[6], (DEPTH, D), 0.01),
        "norm2_g": 1.0 + nrm(ks[7], (DEPTH, D), 0.01),
        "w_in": nrm(ks[8], (DEPTH, D, IN_COLS), D ** -0.5),
        "q_norm_g": 1.0 + nrm(ks[9], (DEPTH, HEAD_DIM), 0.01),
        "k_norm_g": 1.0 + nrm(ks[10], (DEPTH, HEAD_DIM), 0.01),
        "rpb": nrm(ks[11], (DEPTH, NA_HEADS, 2 * NA_WIN_H - 1, 2 * NA_WIN_W - 1), 0.02),
        "s5_lam_re": -0.5 + nrm(ks[12], s5_shape, 0.01),
        "s5_lam_im": math.pi * jnp.arange(S5_STATE, dtype=f32) + nrm(ks[13], s5_shape, 0.01),
        "s5_log_step": jax.random.uniform(ks[14], (DEPTH, 2, S5_GROUPS), f32,
                                          math.log(S5_DT_MIN), math.log(S5_DT_MAX)),
        "s5_b_re": nrm(ks[15], s5_shape + (S5_GROUP,), (2 * S5_GROUP) ** -0.5),
        "s5_b_im": nrm(ks[16], s5_shape + (S5_GROUP,), (2 * S5_GROUP) ** -0.5),
        "s5_c_re": nrm(ks[17], (DEPTH, 2, S5_GROUPS, S5_GROUP, S5_STATE), (2 * S5_STATE) ** -0.5),
        "s5_c_im": nrm(ks[18], (DEPTH, 2, S5_GROUPS, S5_GROUP, S5_STATE), (2 * S5_STATE) ** -0.5),
        "s5_d": nrm(ks[19], (DEPTH, S5_WIDTH), 1.0),
        "w_glu": nrm(ks[20], (DEPTH, S5_WIDTH, S5_WIDTH), S5_WIDTH ** -0.5),
        "b_glu": nrm(ks[21], (DEPTH, S5_WIDTH), 0.01),
        "w_fnet": nrm(ks[22], (DEPTH, FNET_HEADS, FNET_HEAD_DIM, FNET_HEAD_DIM), FNET_HEAD_DIM ** -0.5),
        "w_out": nrm(ks[23], (DEPTH, MIX_WIDTH, D), MIX_WIDTH ** -0.5),
        "w_router": nrm(ks[24], (D, N_EXPERTS), D ** -0.5),
        "b_router": nrm(ks[25], (N_EXPERTS,), 0.01),
        "w_gate": nrm(ks[26], (DEPTH, N_EXPERTS, D, EXPERT_FF), D ** -0.5),
        "w_up": nrm(ks[27], (DEPTH, N_EXPERTS, D, EXPERT_FF), D ** -0.5),
        "w_down": nrm(ks[28], (DEPTH, N_EXPERTS, EXPERT_FF, D), EXPERT_FF ** -0.5),
    }


def reference(x, c, ctx, c_ctx, w_ada, b_ada, norm1_g, norm2_g, w_in, q_norm_g, k_norm_g, rpb,
              s5_lam_re, s5_lam_im, s5_log_step, s5_b_re, s5_b_im, s5_c_re, s5_c_im, s5_d,
              w_glu, b_glu, w_fnet, w_out, w_router, b_router, w_gate, w_up, w_down):
    B, L, D = x.shape
    rope_cos, rope_sin = axial_rope(L)
    silu_c = jax.nn.silu(c)
    silu_cc = jax.nn.silu(c_ctx)
    xc = ctx
    for l in range(DEPTH):
        ctx_out = l < DEPTH - 1
        mod = jnp.split((silu_c @ w_ada[l] + b_ada[l])[:, None, :], 6, axis=-1)
        mod_c = jnp.split(silu_cc @ w_ada[l] + b_ada[l], 6, axis=-1)
        h = rms_norm(x, norm1_g[l]) * (1 + mod[1]) + mod[0]
        hc = rms_norm(xc, norm1_g[l]) * (1 + mod_c[1]) + mod_c[0]
        o, oc = token_mixers(h, hc, rope_cos, rope_sin, w_in[l], q_norm_g[l], k_norm_g[l], rpb[l],
                             s5_lam_re[l], s5_lam_im[l], s5_log_step[l], s5_b_re[l], s5_b_im[l],
                             s5_c_re[l], s5_c_im[l], s5_d[l], w_glu[l], b_glu[l], w_fnet[l], w_out[l],
                             ctx_out)
        x = x + mod[2] * o
        h2 = rms_norm(x, norm2_g[l]) * (1 + mod[4]) + mod[3]
        if ctx_out:
            xc = xc + mod_c[2] * oc
            h2c = rms_norm(xc, norm2_g[l]) * (1 + mod_c[4]) + mod_c[3]
            tokens = jnp.concatenate([h2.reshape(-1, D), h2c.reshape(-1, D)], axis=0)
            y = moe_ffn(tokens, w_router, b_router, w_gate[l], w_up[l], w_down[l])
            x = x + mod[5] * y[:B * L].reshape(B, L, D)
            xc = xc + mod_c[5] * y[B * L:].reshape(B, -1, D)
        else:
            y = moe_ffn(h2.reshape(-1, D), w_router, b_router, w_gate[l], w_up[l], w_down[l])
            x = x + mod[5] * y.reshape(B, L, D)
    return x
```

```cpp
#include <hip/hip_runtime.h>
#include <cstdio>
#include <cstdint>

#define LAS __attribute__((address_space(3)))
typedef unsigned short bf16_t;
typedef short bf16x8 __attribute__((ext_vector_type(8)));
typedef float f32x4 __attribute__((ext_vector_type(4)));
typedef unsigned u32x2 __attribute__((ext_vector_type(2)));
typedef unsigned u32x4 __attribute__((ext_vector_type(4)));

constexpr int DM = 1024, NB = 16, SEQ = 2048, LC = 256, TLAT = NB * SEQ, TCTX = NB * LC, TT = TLAT + TCTX;
constexpr int NIN = 2304;
constexpr int NCLS = 24;
constexpr int NCH = 36;
constexpr int NTHR = 512;

constexpr size_t al256(size_t x) { return (x + 255) & ~(size_t)255; }
constexpr size_t WS_CTL = 0;
constexpr size_t CTL_BYTES = 65536;
constexpr size_t WS_MOD = WS_CTL + CTL_BYTES;
constexpr size_t WS_ROPE = al256(WS_MOD + (size_t)2 * 17 * 6144 * 4);
constexpr size_t WS_WIN = al256(WS_ROPE + (size_t)2 * 2048 * 32 * 4);
constexpr size_t WS_WOUT = al256(WS_WIN + (size_t)2 * NIN * 1024 * 2);
constexpr size_t WS_WGLU = al256(WS_WOUT + (size_t)2 * 1024 * 1024 * 2);
constexpr size_t WS_WG = al256(WS_WGLU + (size_t)2 * 256 * 256 * 2);
constexpr size_t WS_WU = al256(WS_WG + (size_t)2 * 16 * 512 * 1024 * 2);
constexpr size_t WS_WD = al256(WS_WU + (size_t)2 * 16 * 512 * 1024 * 2);
constexpr size_t WS_DFTL = al256(WS_WD + (size_t)2 * 16 * 1024 * 512 * 2);
constexpr size_t WS_DFTC = al256(WS_DFTL + (size_t)2048 * 4096 * 2);
constexpr size_t WS_PM = al256(WS_DFTC + (size_t)256 * 512 * 2);
constexpr size_t WS_KC = al256(WS_PM + (size_t)2 * 16 * 256 * 1024 * 2);
constexpr size_t WS_QT = al256(WS_KC + (size_t)2 * 16 * 128 * 256 * 2);
constexpr size_t WS_LAM64 = al256(WS_QT + (size_t)2 * 16 * 1024 * 256 * 2);
constexpr size_t WS_XC = al256(WS_LAM64 + (size_t)2 * 16 * 2 * 64 * 2 * 4);
constexpr size_t WS_HBUF = al256(WS_XC + (size_t)TCTX * 1024 * 4);
constexpr size_t WS_YB = WS_HBUF;
constexpr size_t WS_RB = al256(WS_HBUF + (size_t)TT * 1024 * 2);
constexpr size_t WS_Q = WS_RB;
constexpr size_t WS_K = al256(WS_Q + (size_t)TT * 512 * 2);
constexpr size_t WS_VTL = al256(WS_K + (size_t)TT * 512 * 2);
constexpr size_t WS_VTC = al256(WS_VTL + (size_t)16 * 512 * 2048 * 2);
constexpr size_t WS_US = al256(WS_VTC + (size_t)16 * 512 * 256 * 2);
constexpr size_t WS_GTL = al256(WS_US + (size_t)TT * 256 * 2);
constexpr size_t WS_GTC = al256(WS_GTL + (size_t)16 * 512 * 2048 * 2);
constexpr size_t WS_HS = al256(WS_GTC + (size_t)16 * 512 * 256 * 2);
constexpr size_t WS_RB_END = al256(WS_HS + (size_t)256 * 64 * 256 * 2);
constexpr size_t WS_HMOE = WS_RB;
static_assert(WS_RB + (size_t)(TT + NCLS * 256) * 1024 * 2 <= WS_RB_END, "HMOE must fit region B");
constexpr size_t WS_MIX = WS_RB_END;
constexpr size_t WS_PERM = al256(WS_MIX + (size_t)TT * 1024 * 2);
constexpr size_t WS_TOKW = al256(WS_PERM + (size_t)NCLS * TT * 4);
constexpr size_t WS_END = al256(WS_TOKW + (size_t)TT * 8);
static_assert(WS_END <= (size_t)512 * 1024 * 1024, "workspace map exceeds 512 MiB");

#define XB_TMO      128
#define XB_XCNT(j)  (256  + 64 * (j))
#define XB_XSUB(j)  (1280 + 64 * (j))
#define XB_XGEN(j)  (2304 + 64 * (j))
#define XB_TOP      3328
#define XB_TOPGEN   3392
#define XCD_BAR_WORDS 3456
#define XB_SPIN_CAP (1u << 18)
__device__ __forceinline__ unsigned xb_ld(unsigned* p)              { return __hip_atomic_load(p, __ATOMIC_RELAXED, __HIP_MEMORY_SCOPE_AGENT); }
__device__ __forceinline__ unsigned xb_add(unsigned* p, unsigned v) { return __hip_atomic_fetch_add(p, v, __ATOMIC_RELAXED, __HIP_MEMORY_SCOPE_AGENT); }
__device__ __forceinline__ unsigned xb_xcc_id() { return (unsigned)__builtin_amdgcn_s_getreg((3 << 11) | 20) & 0xFu; }
#define XB_SPIN(cond, bar) do { unsigned _sp = 0; while (cond) { __builtin_amdgcn_s_sleep(1); \
    if ((++_sp & 255u) == 0u) { if (xb_ld(&(bar)[XB_TMO])) break; if (_sp > XB_SPIN_CAP) { atomicAdd(&(bar)[XB_TMO], 1u); break; } } } } while (0)
struct XcdBarrier { unsigned* bar; unsigned x; volatile LAS unsigned* st; };
__device__ __forceinline__ XcdBarrier xcd_barrier_post(unsigned* bar, volatile LAS unsigned* st) {
    XcdBarrier b; b.bar = bar; b.x = xb_xcc_id(); b.st = st;
    if (threadIdx.x == 0) (void)xb_add(&bar[XB_XCNT(b.x)], 1u);
    return b;
}
__device__ __forceinline__ void xcd_barrier_complete(unsigned* bar, unsigned x, unsigned& nloc, unsigned& nx) {
    const unsigned G = gridDim.x * gridDim.y * gridDim.z;
    unsigned sum, cnt, mine, sp = 0u;
    for (;;) {
        sum = 0u; cnt = 0u; mine = 0u;
#pragma unroll
        for (unsigned j = 0; j < 16; ++j) { const unsigned c = xb_ld(&bar[XB_XCNT(j)]); sum += c; cnt += (c > 0u) ? 1u : 0u; mine = (j == x) ? c : mine; }
        if (sum == G) break;
        __builtin_amdgcn_s_sleep(1);
        if ((++sp & 255u) == 0u) { if (xb_ld(&bar[XB_TMO])) break; if (sp > XB_SPIN_CAP) { atomicAdd(&bar[XB_TMO], 1u); break; } }
    }
    nloc = mine > 0u ? mine : 1u; nx = cnt > 0u ? cnt : 1u;
}
__device__ __forceinline__ void xcd_barrier(const XcdBarrier& b) {
    asm volatile("s_waitcnt vmcnt(0)" ::: "memory");
    __syncthreads();
    if (threadIdx.x == 0) {
        unsigned* bar = b.bar;
        __builtin_amdgcn_s_waitcnt(0);
        unsigned nloc = b.st[0], nx = b.st[1];
        if (nloc == 0u) { xcd_barrier_complete(bar, b.x, nloc, nx); b.st[0] = nloc; b.st[1] = nx; }
        const unsigned old = xb_add(&bar[XB_XSUB(b.x)], 1u);
        const unsigned gen = old / nloc;
        if (old + 1u == (gen + 1u) * nloc) {
            __builtin_amdgcn_fence(__ATOMIC_RELEASE, "agent");
            asm volatile("s_waitcnt vmcnt(0)" ::: "memory");
            const unsigned og = xb_add(&bar[XB_TOP], 1u);
            const unsigned tg = og / nx;
            if (og + 1u == (tg + 1u) * nx) xb_add(&bar[XB_TOPGEN], 1u);
            else XB_SPIN(xb_ld(&bar[XB_TOPGEN]) == tg, bar);
            __builtin_amdgcn_fence(__ATOMIC_ACQUIRE, "agent");
            xb_add(&bar[XB_XGEN(b.x)], 1u);
            asm volatile("s_waitcnt vmcnt(0)" ::: "memory");
        } else {
            XB_SPIN(xb_ld(&bar[XB_XGEN(b.x)]) == gen, bar);
            __builtin_amdgcn_fence(__ATOMIC_ACQUIRE, "agent");
            asm volatile("s_waitcnt vmcnt(0)" ::: "memory");
        }
    }
    __syncthreads();
}

__device__ __forceinline__ unsigned cvt_pk_bf16(float lo, float hi) { unsigned r; asm volatile("v_cvt_pk_bf16_f32 %0, %1, %2" : "=v"(r) : "v"(lo), "v"(hi)); return r; }
__device__ __forceinline__ bf16_t f2bf(float f) { return (bf16_t)(cvt_pk_bf16(f, 0.f) & 0xffffu); }
__device__ __forceinline__ float bf2f(bf16_t b) { return __uint_as_float(((unsigned)b) << 16); }
__device__ __forceinline__ float sigmoidf_(float x) { return 1.0f / (1.0f + __expf(-x)); }
__device__ __forceinline__ float siluf_(float x) { return x / (1.0f + __expf(-x)); }
__device__ __forceinline__ float gelu_tanh(float x) { const float z = 0.7978845608028654f * (x + 0.044715f * x * x * x); const float e = __expf(2.0f * z); return 0.5f * x * (2.0f - 2.0f / (e + 1.0f)); }
__device__ __forceinline__ float wave_sum(float v) {
#pragma unroll
    for (int o = 32; o > 0; o >>= 1) v += __shfl_xor(v, o);
    return v;
}

__device__ __forceinline__ int otid() { int t = threadIdx.x; asm volatile("" : "+v"(t)); return t; }

struct Args {
    const float* in[29];
    float* out;
    unsigned char* ws;
    int ph_lo, ph_hi;
};

__device__ __forceinline__ int row_batch(int m) { return m < TLAT ? (m >> 11) : 16; }
__device__ __forceinline__ float* stream_row(const Args& a, int m) { return m < TLAT ? a.out + (size_t)m * DM : (float*)(a.ws + WS_XC) + (size_t)(m - TLAT) * DM; }
__device__ __forceinline__ const float* input_row(const Args& a, int m) { return m < TLAT ? a.in[0] + (size_t)m * DM : a.in[2] + (size_t)(m - TLAT) * DM; }

constexpr int LDP = 72;
template <int BM, int BN> constexpr int gemm_lds_bytes() { return 2 * (BM + BN) * LDP * 2; }

template <int BM, int BN, int WM, int WN, bool TR, class AL, class BL, class EP>
__device__ __forceinline__ void gemm_tile(unsigned char* lds, const int K, const AL& al, const BL& bl, const EP& ep) {
    static_assert(WM * WN == 8, "8 waves");
    constexpr int WTM = BM / WM, WTN = BN / WN, MI = WTM / 16, NI = WTN / 16;
    constexpr int NA = (BM * 8 + NTHR - 1) / NTHR, NBc = (BN * 8 + NTHR - 1) / NTHR;
    const int tid = otid(), lane = tid & 63, wid = tid >> 6, wm = wid / WN, wn = wid % WN;
    bf16_t* As = (bf16_t*)lds;
    bf16_t* Bs = As + 2 * BM * LDP;
    bf16x8 ra[NA], rb[NBc];
    f32x4 acc[MI][NI];
#pragma unroll
    for (int i = 0; i < MI; ++i)
#pragma unroll
        for (int j = 0; j < NI; ++j) acc[i][j] = (f32x4){0.f, 0.f, 0.f, 0.f};
    auto gload = [&](int k0) {
#pragma unroll
        for (int i = 0; i < NA; ++i) { const int q = tid + i * NTHR; if (BM * 8 >= NTHR * (i + 1) || q < BM * 8) ra[i] = *(const bf16x8*)al(q >> 3, k0 + (q & 7) * 8); }
#pragma unroll
        for (int i = 0; i < NBc; ++i) { const int q = tid + i * NTHR; if (BN * 8 >= NTHR * (i + 1) || q < BN * 8) rb[i] = *(const bf16x8*)bl(q >> 3, k0 + (q & 7) * 8); }
    };
    auto lstore = [&](int buf) {
#pragma unroll
        for (int i = 0; i < NA; ++i) { const int q = tid + i * NTHR; if (BM * 8 >= NTHR * (i + 1) || q < BM * 8) *(bf16x8*)(As + (buf * BM + (q >> 3)) * LDP + (q & 7) * 8) = ra[i]; }
#pragma unroll
        for (int i = 0; i < NBc; ++i) { const int q = tid + i * NTHR; if (BN * 8 >= NTHR * (i + 1) || q < BN * 8) *(bf16x8*)(Bs + (buf * BN + (q >> 3)) * LDP + (q & 7) * 8) = rb[i]; }
    };
    const int nk = K / 64;
    gload(0); lstore(0); __syncthreads();
#pragma unroll 1
    for (int kt = 0; kt < nk; ++kt) {
        const int buf = kt & 1;
        if (kt + 1 < nk) gload((kt + 1) * 64);
        const bf16_t* Ab = As + (buf * BM + wm * WTM + (lane & 15)) * LDP + (lane >> 4) * 8;
        const bf16_t* Bb = Bs + (buf * BN + wn * WTN + (lane & 15)) * LDP + (lane >> 4) * 8;
#pragma unroll
        for (int ks = 0; ks < 2; ++ks) {
            bf16x8 af[MI], bfr[NI];
#pragma unroll
            for (int i = 0; i < MI; ++i) af[i] = *(const bf16x8*)(Ab + i * 16 * LDP + ks * 32);
#pragma unroll
            for (int j = 0; j < NI; ++j) bfr[j] = *(const bf16x8*)(Bb + j * 16 * LDP + ks * 32);
#pragma unroll
            for (int i = 0; i < MI; ++i)
#pragma unroll
                for (int j = 0; j < NI; ++j)
                    acc[i][j] = TR ? __builtin_amdgcn_mfma_f32_16x16x32_bf16(bfr[j], af[i], acc[i][j], 0, 0, 0)
                                   : __builtin_amdgcn_mfma_f32_16x16x32_bf16(af[i], bfr[j], acc[i][j], 0, 0, 0);
        }
        if (kt + 1 < nk) lstore(buf ^ 1);
        __syncthreads();
    }
    ep(acc, wm * WTM, wn * WTN, lane);
}

__device__ void pro_mod(const Args& a, unsigned char* lds, int unit) {
    const int tid = otid(), lane = tid & 63, wid = tid >> 6;
    float* sl = (float*)lds;
    float* part = sl + 17 * 1024;
    for (int i = tid; i < 17 * 1024; i += NTHR) { const int r = i >> 10, k = i & 1023; const float v = r < 16 ? a.in[1][r * 1024 + k] : a.in[3][k]; sl[i] = siluf_(v); }
    __syncthreads();
    const int l = unit / 96, n = (unit % 96) * 64 + lane;
    const float* w = a.in[4] + (size_t)l * 1024 * 6144 + n;
    float acc[17];
#pragma unroll
    for (int r = 0; r < 17; ++r) acc[r] = 0.f;
    for (int k = wid * 128; k < wid * 128 + 128; ++k) {
        const float wv = w[(size_t)k * 6144];
#pragma unroll
        for (int r = 0; r < 17; ++r) acc[r] += sl[r * 1024 + k] * wv;
    }
#pragma unroll
    for (int r = 0; r < 17; ++r) part[(wid * 17 + r) * 64 + lane] = acc[r];
    __syncthreads();
    float* mod = (float*)(a.ws + WS_MOD);
    for (int i = tid; i < 17 * 64; i += NTHR) {
        const int r = i >> 6, c = i & 63; float s = 0.f;
#pragma unroll
        for (int w8 = 0; w8 < 8; ++w8) s += part[(w8 * 17 + r) * 64 + c];
        const int nn = (unit % 96) * 64 + c;
        mod[((size_t)l * 17 + r) * 6144 + nn] = s + a.in[5][l * 6144 + nn];
    }
    __syncthreads();
}
__device__ void pro_tr64(const float* src, int lds_src, bf16_t* dst, int ld_dst, int k0, int n0, unsigned char* lds) {
    float* t = (float*)lds;
    const int tid = otid();
#pragma unroll
    for (int i = 0; i < 8; ++i) { const int e = tid + i * NTHR, r = e >> 6, c = e & 63; t[r * 65 + c] = src[(size_t)(k0 + r) * lds_src + n0 + c]; }
    __syncthreads();
#pragma unroll
    for (int i = 0; i < 4; ++i) { const int e = tid + i * NTHR, n = e >> 5, kp = (e & 31) * 2;
        *(unsigned*)(dst + (size_t)(n0 + n) * ld_dst + k0 + kp) = cvt_pk_bf16(t[kp * 65 + n], t[(kp + 1) * 65 + n]); }
    __syncthreads();
}
__device__ void pro_fold(const Args& a, unsigned char* lds, int unit) {
    const int tid = otid(), lane = tid & 63, wid = tid >> 6;
    float* ct = (float*)lds; float* st = ct + 64;
    float* xs = st + 64 + wid * 192; float* as = xs + 64; float* ss = as + 64;
    if (tid < 64) { ct[tid] = cospif((float)tid / 32.0f); st[tid] = sinpif((float)tid / 32.0f); }
    __syncthreads();
    const int l = unit >> 7, kk = (unit & 127) * 8 + wid;
    bf16_t* wt = (bf16_t*)(a.ws + WS_WIN) + (size_t)l * NIN * 1024;
    for (int h = 0; h < 4; ++h) {
        xs[lane] = a.in[8][((size_t)l * 1024 + kk) * 2048 + 1792 + h * 64 + lane];
        __builtin_amdgcn_wave_barrier();
        float ac = 0.f, as_ = 0.f;
        for (int d = 0; d < 64; ++d) { const float x = xs[d]; const int j = (lane * d) & 63; ac += x * ct[j]; as_ += x * st[j]; }
        as[lane] = ac; ss[lane] = as_;
        __builtin_amdgcn_wave_barrier();
        const float* wf = a.in[22] + ((size_t)l * 4 + h) * 4096;
        float gc = 0.f, gs = 0.f;
        for (int k2 = 0; k2 < 64; ++k2) { const float w = wf[k2 * 64 + lane]; gc += as[k2] * w; gs += ss[k2] * w; }
        wt[(size_t)(1792 + h * 64 + lane) * 1024 + kk] = f2bf(gc);
        wt[(size_t)(2048 + h * 64 + lane) * 1024 + kk] = f2bf(gs);
        __builtin_amdgcn_wave_barrier();
    }
    __syncthreads();
}
__device__ void pro_dft(const Args& a, int unit) {
    const int tid = otid();
    if (unit < 2048) {
        bf16_t* d = (bf16_t*)(a.ws + WS_DFTL) + (size_t)unit * 4096;
        const float sc = 0.0027621358640099513f;
        for (int c = tid; c < 2048; c += NTHR) { const float x = (float)((unit * c) & 2047) * (1.0f / 1024.0f); d[c] = f2bf(cospif(x) * sc); d[2048 + c] = f2bf(-sinpif(x) * sc); }
    } else {
        const float sc = 0.0078125f;
        const int k1 = (unit - 2048) * 8 + (tid >> 6);
        bf16_t* d = (bf16_t*)(a.ws + WS_DFTC) + (size_t)k1 * 512;
        for (int c = tid & 63; c < 256; c += 64) { const float x = (float)((k1 * c) & 255) * (1.0f / 128.0f); d[c] = f2bf(cospif(x) * sc); d[256 + c] = f2bf(-sinpif(x) * sc); }
    }
}
__device__ void pro_rope(const Args& a, int unit) {
    float* rc = (float*)(a.ws + WS_ROPE); float* rs = rc + 2048 * 32;
    const int e = unit * NTHR + otid(), t = e >> 5, i = e & 31;
    const float pos = (float)(i < 16 ? (t >> 6) : (t & 63));
    const float invf = powf(100.0f, -(float)(i & 15) / 16.0f);
    float s, c; sincosf(pos * invf, &s, &c); rc[e] = c; rs[e] = s;
}
__device__ void pro_s5(const Args& a, unsigned char* lds, int unit) {
    const int tid = otid();
    const int l = unit >> 7, g = (unit >> 3) & 15, part = unit & 7;
    float2* lp = (float2*)lds;
    float2* bb = lp + 2 * 65 * 64;
    float2* cm = bb + 2 * 64 * 16;
    for (int i = tid; i < 2 * 65 * 64; i += NTHR) {
        const int d = i / (65 * 64), j = (i / 64) % 65, p = i & 63;
        const int pi = ((l * 2 + d) * 16 + g) * 64 + p;
        const float step = expf(a.in[14][(l * 2 + d) * 16 + g]);
        const float re = a.in[12][pi] * step * (float)j, im = a.in[13][pi] * step * (float)j;
        float s, c; sincosf(im, &s, &c); const float m = expf(re);
        lp[i] = make_float2(m * c, m * s);
    }
    __syncthreads();
    for (int i = tid; i < 2 * 64 * 16; i += NTHR) {
        const int d = i >> 10, p = (i >> 4) & 63, c = i & 15;
        const int pi = ((l * 2 + d) * 16 + g) * 64 + p;
        const float lr = a.in[12][pi], li = a.in[13][pi];
        const float2 lb = lp[(d * 65 + 1) * 64 + p];
        const float nr = lb.x - 1.0f, ni = lb.y, den = lr * lr + li * li;
        const float qr = (nr * lr + ni * li) / den, qi = (ni * lr - nr * li) / den;
        const float br = a.in[15][(size_t)pi * 16 + c], bi = a.in[16][(size_t)pi * 16 + c];
        bb[i] = make_float2(qr * br - qi * bi, qr * bi + qi * br);
    }
    for (int i = tid; i < 2 * 16 * 64; i += NTHR) {
        const int d = i >> 10, c = (i >> 6) & 15, p = i & 63;
        const size_t ci = ((((size_t)l * 2 + d) * 16 + g) * 16 + c) * 64 + p;
        cm[i] = make_float2(a.in[17][ci], a.in[18][ci]);
    }
    __syncthreads();
    const size_t lg = (size_t)l * 16 + g;
    { bf16_t* pm = (bf16_t*)(a.ws + WS_PM) + lg * 256 * 1024;
      for (int i = tid; i < 32 * 1024; i += NTHR) {
          const int n = part * 32 + (i >> 10), k = i & 1023, d = n >> 7, p = (n >> 1) & 63, ri = n & 1, s = k >> 4, c = k & 15;
          const float2 pw = lp[(d * 65 + (d == 0 ? 63 - s : s)) * 64 + p], b = bb[(d * 64 + p) * 16 + c];
          pm[(size_t)n * 1024 + k] = f2bf(ri == 0 ? pw.x * b.x - pw.y * b.y : pw.x * b.y + pw.y * b.x);
      } }
    { bf16_t* qt = (bf16_t*)(a.ws + WS_QT) + lg * 1024 * 256;
      for (int i = tid; i < 128 * 256; i += NTHR) {
          const int n = part * 128 + (i >> 8), k = i & 255, t = n >> 4, c = n & 15, d = k >> 7, p = (k >> 1) & 63, ri = k & 1;
          const float2 pw = lp[(d * 65 + (d == 0 ? t + 1 : 64 - t)) * 64 + p], cc = cm[(d * 16 + c) * 64 + p];
          qt[(size_t)n * 256 + k] = f2bf(ri == 0 ? cc.x * pw.x - cc.y * pw.y : -(cc.x * pw.y + cc.y * pw.x));
      } }
    { bf16_t* kc = (bf16_t*)(a.ws + WS_KC) + lg * 128 * 256;
      for (int i = tid; i < 16 * 256; i += NTHR) {
          const int jj = part * 16 + (i >> 8), c = (i >> 4) & 15, c2 = i & 15;
          float v = 0.f;
          if (jj <= 126) {
              const int j = jj - 63;
              if (j >= 0) { for (int p = 0; p < 64; ++p) { const float2 pw = lp[(0 * 65 + j) * 64 + p], b = bb[(0 * 64 + p) * 16 + c2], cc = cm[(0 * 16 + c) * 64 + p];
                      const float tr = pw.x * b.x - pw.y * b.y, ti = pw.x * b.y + pw.y * b.x; v += cc.x * tr - cc.y * ti; } }
              if (j <= 0) { for (int p = 0; p < 64; ++p) { const float2 pw = lp[(1 * 65 - j) * 64 + p], b = bb[(1 * 64 + p) * 16 + c2], cc = cm[(1 * 16 + c) * 64 + p];
                      const float tr = pw.x * b.x - pw.y * b.y, ti = pw.x * b.y + pw.y * b.x; v += cc.x * tr - cc.y * ti; } }
              if (j == 0 && c == c2) v += a.in[19][l * 256 + g * 16 + c];
          }
          kc[(size_t)jj * 256 + c * 16 + c2] = f2bf(v);
      } }
    if (part == 0 && tid < 128) { const int d = tid >> 6, p = tid & 63; const float2 v = lp[(d * 65 + 64) * 64 + p];
        float* o = (float*)(a.ws + WS_LAM64) + ((lg * 2 + d) * 64 + p) * 2; o[0] = v.x; o[1] = v.y; }
    __syncthreads();
}

__device__ void phase_prologue(const Args& a, unsigned char* lds) {
    const int G = gridDim.x;
    constexpr int U_MOD = 192, U_FOLD = 256, U_S5 = 256, U_DFT = 2048 + 32, U_ROPE = 128;
    constexpr int T_WIN = 2 * 16 * 28, T_WOUT = 2 * 16 * 16, T_WGLU = 2 * 4 * 4, T_WG = 32 * 16 * 8, T_WD = 32 * 8 * 16;
    constexpr int U_TOT = U_MOD + U_FOLD + U_S5 + U_DFT + U_ROPE + T_WIN + T_WOUT + T_WGLU + 2 * T_WG + T_WD;
    for (int u0 = blockIdx.x; u0 < U_TOT; u0 += G) {
        int u = u0;
        if (u < U_MOD) { pro_mod(a, lds, u); continue; } u -= U_MOD;
        if (u < U_FOLD) { pro_fold(a, lds, u); continue; } u -= U_FOLD;
        if (u < U_S5) { pro_s5(a, lds, u); continue; } u -= U_S5;
        if (u < U_DFT) { pro_dft(a, u); continue; } u -= U_DFT;
        if (u < U_ROPE) { pro_rope(a, u); continue; } u -= U_ROPE;
        if (u < T_WIN) { const int l = u / (16 * 28), r = u % (16 * 28);
            pro_tr64(a.in[8] + (size_t)l * 1024 * 2048, 2048, (bf16_t*)(a.ws + WS_WIN) + (size_t)l * NIN * 1024, 1024, (r / 28) * 64, (r % 28) * 64, lds); continue; } u -= T_WIN;
        if (u < T_WOUT) { const int l = u >> 8, r = u & 255;
            pro_tr64(a.in[23] + (size_t)l * 1024 * 1024, 1024, (bf16_t*)(a.ws + WS_WOUT) + (size_t)l * 1024 * 1024, 1024, (r >> 4) * 64, (r & 15) * 64, lds); continue; } u -= T_WOUT;
        if (u < T_WGLU) { const int l = u >> 4, r = u & 15;
            pro_tr64(a.in[20] + (size_t)l * 256 * 256, 256, (bf16_t*)(a.ws + WS_WGLU) + (size_t)l * 256 * 256, 256, (r >> 2) * 64, (r & 3) * 64, lds); continue; } u -= T_WGLU;
        if (u < 2 * T_WG) { const int which = u / T_WG, v = u % T_WG, le = v >> 7, r = v & 127;
            pro_tr64(a.in[26 + which] + (size_t)le * 1024 * 512, 512, (bf16_t*)(a.ws + (which ? WS_WU : WS_WG)) + (size_t)le * 512 * 1024, 1024, (r >> 3) * 64, (r & 7) * 64, lds); continue; } u -= 2 * T_WG;
        { const int le = u >> 7, r = u & 127;
            pro_tr64(a.in[28] + (size_t)le * 512 * 1024, 1024, (bf16_t*)(a.ws + WS_WD) + (size_t)le * 1024 * 512, 512, (r >> 4) * 64, (r & 15) * 64, lds); }
    }
}

__device__ void phase_norm1(const Args& a, int l) {
    const int lane = otid() & 63, gw = blockIdx.x * 8 + (otid() >> 6), nw = gridDim.x * 8;
    const float* g1 = a.in[6] + l * 1024;
    const float* mod = (const float*)(a.ws + WS_MOD) + (size_t)l * 17 * 6144;
    bf16_t* hb = (bf16_t*)(a.ws + WS_HBUF);
    for (int m = gw; m < TT; m += nw) {
        const float* xr = (l == 0) ? input_row(a, m) : stream_row(a, m);
        const float* mr = mod + (size_t)row_batch(m) * 6144;
        f32x4 v[4]; float ss = 0.f;
#pragma unroll
        for (int i = 0; i < 4; ++i) { v[i] = *(const f32x4*)(xr + i * 256 + lane * 4); ss += v[i][0] * v[i][0] + v[i][1] * v[i][1] + v[i][2] * v[i][2] + v[i][3] * v[i][3]; }
        ss = wave_sum(ss);
        const float rstd = rsqrtf(ss * (1.0f / 1024.0f) + 1e-6f);
#pragma unroll
        for (int i = 0; i < 4; ++i) {
            const int c = i * 256 + lane * 4;
            const f32x4 g = *(const f32x4*)(g1 + c), sh = *(const f32x4*)(mr + c), sc = *(const f32x4*)(mr + 1024 + c);
            float o[4];
#pragma unroll
            for (int j = 0; j < 4; ++j) o[j] = v[i][j] * rstd * g[j] * (1.0f + sc[j]) + sh[j];
            u32x2 w; w.x = cvt_pk_bf16(o[0], o[1]); w.y = cvt_pk_bf16(o[2], o[3]);
            *(u32x2*)(hb + (size_t)m * 1024 + c) = w;
        }
    }
}

struct AlRow { const bf16_t* base; int ld; __device__ __forceinline__ const bf16_t* operator()(int m, int k) const { return base + (size_t)m * ld + k; } };

struct EpQK {
    bf16_t* dst; const float* g; const float* rope; int m0, c0; bool latent;
    __device__ __forceinline__ void operator()(f32x4 (&acc)[4][4], int wm0, int wn0, int lane) const {
        const int fr = lane & 15, fq = lane >> 4;
        f32x4 gv[4];
#pragma unroll
        for (int ni = 0; ni < 4; ++ni) gv[ni] = *(const f32x4*)(g + ni * 16 + fq * 4);
#pragma unroll
        for (int mi = 0; mi < 4; ++mi) {
            const int m = m0 + wm0 + mi * 16 + fr;
            float ss = 0.f;
#pragma unroll
            for (int ni = 0; ni < 4; ++ni)
#pragma unroll
                for (int j = 0; j < 4; ++j) ss += acc[mi][ni][j] * acc[mi][ni][j];
            ss += __shfl_xor(ss, 16); ss += __shfl_xor(ss, 32);
            const float rstd = rsqrtf(ss * (1.0f / 64.0f) + 1e-6f);
            f32x4 y[4];
#pragma unroll
            for (int ni = 0; ni < 4; ++ni)
#pragma unroll
                for (int j = 0; j < 4; ++j) y[ni][j] = acc[mi][ni][j] * rstd * gv[ni][j];
            if (latent) {
                const int pos = m & 2047;
#pragma unroll
                for (int ni = 0; ni < 2; ++ni) {
                    const f32x4 cs = *(const f32x4*)(rope + pos * 32 + ni * 16 + fq * 4), sn = *(const f32x4*)(rope + 2048 * 32 + pos * 32 + ni * 16 + fq * 4);
#pragma unroll
                    for (int j = 0; j < 4; ++j) { const float x1 = y[ni][j], x2 = y[ni + 2][j]; y[ni][j] = x1 * cs[j] - x2 * sn[j]; y[ni + 2][j] = x1 * sn[j] + x2 * cs[j]; }
                }
            }
#pragma unroll
            for (int ni = 0; ni < 4; ++ni) { u32x2 w; w.x = cvt_pk_bf16(y[ni][0], y[ni][1]); w.y = cvt_pk_bf16(y[ni][2], y[ni][3]);
                *(u32x2*)(dst + (size_t)m * 512 + c0 + wn0 + ni * 16 + fq * 4) = w; }
        }
    }
};
struct EpPlain {
    bf16_t* dst; int ld, m0, c0;
    template <int MI, int NI> __device__ __forceinline__ void operator()(f32x4 (&acc)[MI][NI], int wm0, int wn0, int lane) const {
        const int fr = lane & 15, fq = lane >> 4;
#pragma unroll
        for (int mi = 0; mi < MI; ++mi)
#pragma unroll
            for (int ni = 0; ni < NI; ++ni) { u32x2 w; w.x = cvt_pk_bf16(acc[mi][ni][0], acc[mi][ni][1]); w.y = cvt_pk_bf16(acc[mi][ni][2], acc[mi][ni][3]);
                *(u32x2*)(dst + (size_t)(m0 + wm0 + mi * 16 + fr) * ld + c0 + wn0 + ni * 16 + fq * 4) = w; }
    }
};
struct EpTrans {
    bf16_t* dst; int ldt, l0, c0;
    template <int MI, int NI> __device__ __forceinline__ void operator()(f32x4 (&acc)[MI][NI], int wm0, int wn0, int lane) const {
        const int fr = lane & 15, fq = lane >> 4;
#pragma unroll
        for (int mi = 0; mi < MI; ++mi)
#pragma unroll
            for (int ni = 0; ni < NI; ++ni) { u32x2 w; w.x = cvt_pk_bf16(acc[mi][ni][0], acc[mi][ni][1]); w.y = cvt_pk_bf16(acc[mi][ni][2], acc[mi][ni][3]);
                *(u32x2*)(dst + (size_t)(c0 + wn0 + ni * 16 + fr) * ldt + l0 + wm0 + mi * 16 + fq * 4) = w; }
    }
};

__device__ void phase_win(const Args& a, unsigned char* lds, int l) {
    constexpr int NT_M = TT / 256, NT_N = NIN / 128;
    const bf16_t* hb = (const bf16_t*)(a.ws + WS_HBUF);
    const bf16_t* wt = (const bf16_t*)(a.ws + WS_WIN) + (size_t)l * NIN * 1024;
    for (int u = blockIdx.x; u < NT_M * NT_N; u += gridDim.x) {
        const int tm = u / NT_N, tn = u % NT_N, m0 = tm * 256, n0 = tn * 128;
        const bool latent = m0 < TLAT;
        const int b = latent ? (m0 >> 11) : ((m0 - TLAT) >> 8);
        const AlRow al{hb + (size_t)m0 * 1024, 1024}, bl{wt + (size_t)n0 * 1024, 1024};
        if (n0 < 1024) {
            const bool isq = n0 < 512;
            EpQK ep{(bf16_t*)(a.ws + (isq ? WS_Q : WS_K)), a.in[isq ? 9 : 10] + l * 64, (const float*)(a.ws + WS_ROPE), m0, n0 - (isq ? 0 : 512), latent};
            gemm_tile<256, 128, 4, 2, true>(lds, 1024, al, bl, ep);
        } else if (n0 < 1536 || n0 >= 1792) {
            const bool isv = n0 < 1536;
            bf16_t* dst = latent ? (bf16_t*)(a.ws + (isv ? WS_VTL : WS_GTL)) + (size_t)b * 512 * 2048 : (bf16_t*)(a.ws + (isv ? WS_VTC : WS_GTC)) + (size_t)b * 512 * 256;
            EpTrans ep{dst, latent ? 2048 : 256, latent ? (m0 & 2047) : 0, n0 - (isv ? 1024 : 1792)};
            gemm_tile<256, 128, 4, 2, false>(lds, 1024, al, bl, ep);
        } else {
            EpPlain ep{(bf16_t*)(a.ws + WS_US), 256, m0, n0 - 1536};
            gemm_tile<256, 128, 4, 2, true>(lds, 1024, al, bl, ep);
        }
    }
}

struct AlS5 { const bf16_t* us; const bf16_t* hs; int b, g;
    __device__ __forceinline__ const bf16_t* operator()(int m, int k) const {
        if (k >= 1024) return hs + (size_t)m * 256 + (k - 1024);
        const int ch = m < NCH ? m : NCH - 1;
        const int tok0 = ch < 4 ? TLAT + b * 256 + ch * 64 : b * 2048 + (ch - 4) * 64;
        return us + (size_t)(tok0 + (k >> 4)) * 256 + g * 16 + (k & 15);
    } };
struct BlS5Y { const bf16_t* kc; const bf16_t* qt; int n0;
    __device__ __forceinline__ const bf16_t* operator()(int nl, int k) const {
        const int n = n0 + nl;
        if (k >= 1024) return qt + (size_t)n * 256 + (k - 1024);
        return kc + (((n >> 4) - (k >> 4) + 63) * 16 + (n & 15)) * 16 + (k & 15);
    } };
struct EpS5S { float* S;
    __device__ __forceinline__ void operator()(f32x4 (&acc)[2][4], int wm0, int wn0, int lane) const {
        const int fr = lane & 15, fq = lane >> 4;
#pragma unroll
        for (int mi = 0; mi < 2; ++mi)
#pragma unroll
            for (int ni = 0; ni < 4; ++ni) *(f32x4*)(S + (wm0 + mi * 16 + fr) * 256 + wn0 + ni * 16 + fq * 4) = acc[mi][ni];
    } };
struct EpS5Y { bf16_t* yb; int b, g, n0;
    __device__ __forceinline__ void operator()(f32x4 (&acc)[2][4], int wm0, int wn0, int lane) const {
        const int fr = lane & 15, fq = lane >> 4;
#pragma unroll
        for (int mi = 0; mi < 2; ++mi) {
            const int ch = wm0 + mi * 16 + fr;
            if (ch < NCH) {
                const int tok0 = ch < 4 ? TLAT + b * 256 + ch * 64 : b * 2048 + (ch - 4) * 64;
#pragma unroll
                for (int ni = 0; ni < 4; ++ni) { const int n = n0 + wn0 + ni * 16 + fq * 4;
                    u32x2 w; w.x = cvt_pk_bf16(gelu_tanh(acc[mi][ni][0]), gelu_tanh(acc[mi][ni][1])); w.y = cvt_pk_bf16(gelu_tanh(acc[mi][ni][2]), gelu_tanh(acc[mi][ni][3]));
                    *(u32x2*)(yb + (size_t)(tok0 + (n >> 4)) * 256 + g * 16 + (n & 15)) = w; }
            }
        }
    } };

__device__ void s5_unit(const Args& a, unsigned char* lds, int l, int unit) {
    const int b = unit >> 4, g = unit & 15, tid = otid();
    const size_t lg = (size_t)l * 16 + g;
    const bf16_t* us = (const bf16_t*)(a.ws + WS_US);
    bf16_t* hs = (bf16_t*)(a.ws + WS_HS) + (size_t)unit * 64 * 256;
    float* S = (float*)lds;
    {
        const AlS5 al{us, hs, b, g}; const AlRow bl{(const bf16_t*)(a.ws + WS_PM) + lg * 256 * 1024, 1024};
        const EpS5S ep{S};
        gemm_tile<64, 256, 2, 4, true>(lds, 1024, al, bl, ep);
    }
    __syncthreads();
    if (tid < 128) {
        const int d = tid >> 6, p = tid & 63;
        const float* lm = (const float*)(a.ws + WS_LAM64) + ((lg * 2 + d) * 64 + p) * 2;
        const float lr = lm[0], li = lm[1];
        float hr = 0.f, hi = 0.f;
#pragma unroll 1
        for (int i = 0; i < NCH; ++i) {
            const int ch = d == 0 ? i : (i < 4 ? 3 - i : NCH + 3 - i);
            *(unsigned*)(hs + (size_t)ch * 256 + d * 128 + p * 2) = cvt_pk_bf16(hr, hi);
            const float sr = S[ch * 256 + d * 128 + p * 2], si = S[ch * 256 + d * 128 + p * 2 + 1];
            const float nr = lr * hr - li * hi + sr, ni = lr * hi + li * hr + si;
            hr = nr; hi = ni;
        }
    }
    __syncthreads();
#pragma unroll 1
    for (int nt = 0; nt < 4; ++nt) {
        const AlS5 al{us, hs, b, g};
        const BlS5Y bl{(const bf16_t*)(a.ws + WS_KC) + lg * 128 * 256, (const bf16_t*)(a.ws + WS_QT) + lg * 1024 * 256, nt * 256};
        const EpS5Y ep{(bf16_t*)(a.ws + WS_YB), b, g, nt * 256};
        gemm_tile<64, 256, 2, 4, true>(lds, 1280, al, bl, ep);
    }
}

struct BlDft { const bf16_t* gt; int L, n0;
    __device__ __forceinline__ const bf16_t* operator()(int nl, int k) const { const int hi = k >= L; return gt + (size_t)((hi ? 256 : 0) + n0 + nl) * L + (k - (hi ? L : 0)); } };

__device__ __forceinline__ void attn_wave(const Args& a, int l, int wu) {
    const int lane = otid() & 63, fr = lane & 15, fq = lane >> 4;
    const bf16_t* Qb = (const bf16_t*)(a.ws + WS_Q); const bf16_t* Kb = (const bf16_t*)(a.ws + WS_K);
    bf16_t* mix = (bf16_t*)(a.ws + WS_MIX);
    const bool latent = wu < 16384;
    int b, h, r = 0, mt, qrow0;
    if (latent) { mt = wu & 3; r = (wu >> 2) & 31; h = (wu >> 7) & 7; b = wu >> 10; qrow0 = b * 2048 + r * 64 + mt * 16; }
    else { const int v = wu - 16384; mt = v & 15; h = (v >> 4) & 7; b = v >> 7; qrow0 = TLAT + b * 256 + mt * 16; }
    const int rs = min(max(r - 4, 0), 24), cb = min(max(mt * 16 - 8, 0), 32);
    bf16x8 qf[2];
#pragma unroll
    for (int kd = 0; kd < 2; ++kd) qf[kd] = *(const bf16x8*)(Qb + (size_t)(qrow0 + fr) * 512 + h * 64 + kd * 32 + fq * 8);
    const int kof = 8 * (fr >> 2) + (fr & 3);
    const int qc = mt * 16 + fr, cs = min(max(qc - 8, 0), 48);
    const float* rp = a.in[11] + ((size_t)l * 8 + h) * 15 * 31;
    const bf16_t* vtl = (const bf16_t*)(a.ws + WS_VTL) + (size_t)(b * 512 + h * 64) * 2048;
    const bf16_t* vtc = (const bf16_t*)(a.ws + WS_VTC) + (size_t)(b * 512 + h * 64) * 256;
    f32x4 o[4];
#pragma unroll
    for (int i = 0; i < 4; ++i) o[i] = (f32x4){0.f, 0.f, 0.f, 0.f};
    float mrun = -1e30f, lrun = 0.f;
#pragma unroll 1
    for (int ch = latent ? 0 : 2; ch < 4; ++ch) {
        const bool loc = ch < 2;
        f32x4 s[4][2];
#pragma unroll
        for (int bi = 0; bi < 4; ++bi) {
            const int blk = (ch & 1) * 4 + bi;
            const int kt0 = loc ? b * 2048 + (rs + blk) * 64 + cb : TLAT + b * 256 + blk * 32;
#pragma unroll
            for (int t = 0; t < 2; ++t) {
                f32x4 c = (f32x4){0.f, 0.f, 0.f, 0.f};
#pragma unroll
                for (int kd = 0; kd < 2; ++kd) {
                    const bf16x8 kf = *(const bf16x8*)(Kb + (size_t)(kt0 + kof + 4 * t) * 512 + h * 64 + kd * 32 + fq * 8);
                    c = __builtin_amdgcn_mfma_f32_16x16x32_bf16(kf, qf[kd], c, 0, 0, 0);
                }
                s[bi][t] = c;
            }
        }
        float mx = -1e30f;
#pragma unroll
        for (int bi = 0; bi < 4; ++bi) {
            const int blk = (ch & 1) * 4 + bi;
            const float* rrow = rp + (loc ? (rs + blk - r + 7) : 0) * 31;
#pragma unroll
            for (int t = 0; t < 2; ++t)
#pragma unroll
                for (int j = 0; j < 4; ++j) {
                    float v = s[bi][t][j] * 0.125f;
                    if (loc) { const int kc = cb + 8 * fq + 4 * t + j; const bool ok = kc >= cs && kc < cs + 16; const int bidx = min(max(kc - qc + 15, 0), 30); v = ok ? v + rrow[bidx] : -1e30f; }
                    s[bi][t][j] = v; mx = fmaxf(mx, v);
                }
        }
        mx = fmaxf(mx, __shfl_xor(mx, 16)); mx = fmaxf(mx, __shfl_xor(mx, 32));
        const float mnew = fmaxf(mrun, mx), scale = __expf(mrun - mnew);
        mrun = mnew;
        float sum = 0.f;
#pragma unroll
        for (int bi = 0; bi < 4; ++bi)
#pragma unroll
            for (int t = 0; t < 2; ++t)
#pragma unroll
                for (int j = 0; j < 4; ++j) { const float e = __expf(s[bi][t][j] - mnew); s[bi][t][j] = e; sum += e; }
        sum += __shfl_xor(sum, 16); sum += __shfl_xor(sum, 32);
        lrun = lrun * scale + sum;
#pragma unroll
        for (int i = 0; i < 4; ++i) o[i] = o[i] * scale;
#pragma unroll
        for (int bi = 0; bi < 4; ++bi) {
            const int blk = (ch & 1) * 4 + bi;
            u32x4 pw; pw.x = cvt_pk_bf16(s[bi][0][0], s[bi][0][1]); pw.y = cvt_pk_bf16(s[bi][0][2], s[bi][0][3]);
            pw.z = cvt_pk_bf16(s[bi][1][0], s[bi][1][1]); pw.w = cvt_pk_bf16(s[bi][1][2], s[bi][1][3]);
            bf16x8 pf; __builtin_memcpy(&pf, &pw, 16);
#pragma unroll
            for (int i = 0; i < 4; ++i) {
                const bf16_t* vp = loc ? vtl + (size_t)(i * 16 + fr) * 2048 + (rs + blk) * 64 + cb + 8 * fq : vtc + (size_t)(i * 16 + fr) * 256 + blk * 32 + 8 * fq;
                const bf16x8 vf = *(const bf16x8*)vp;
                o[i] = __builtin_amdgcn_mfma_f32_16x16x32_bf16(vf, pf, o[i], 0, 0, 0);
            }
        }
    }
    const float inv = 1.0f / lrun;
#pragma unroll
    for (int i = 0; i < 4; ++i) { u32x2 w; w.x = cvt_pk_bf16(o[i][0] * inv, o[i][1] * inv); w.y = cvt_pk_bf16(o[i][2] * inv, o[i][3] * inv);
        *(u32x2*)(mix + (size_t)(qrow0 + fr) * 1024 + h * 64 + i * 16 + fq * 4) = w; }
}

__device__ void phase_mixers(const Args& a, unsigned char* lds, int l) {
    const int G = gridDim.x;
#ifndef NO_S5
    for (int u = blockIdx.x; u < 256; u += G) { s5_unit(a, lds, l, u); __syncthreads(); }
#endif
#ifndef NO_DFT
    const int nd = 256 + (l == 0 ? 32 : 0);
    for (int u = blockIdx.x; u < nd; u += G) {
        if (u < 256) { const int b = u >> 4, tm = (u >> 1) & 7, tn = u & 1;
            const AlRow al{(const bf16_t*)(a.ws + WS_DFTL) + (size_t)tm * 256 * 4096, 4096};
            const BlDft bl{(const bf16_t*)(a.ws + WS_GTL) + (size_t)b * 512 * 2048, 2048, tn * 128};
            const EpPlain ep{(bf16_t*)(a.ws + WS_MIX), 1024, b * 2048 + tm * 256, 768 + tn * 128};
            gemm_tile<256, 128, 4, 2, true>(lds, 4096, al, bl, ep);
        } else { const int v = u - 256, b = v >> 1, tn = v & 1;
            const AlRow al{(const bf16_t*)(a.ws + WS_DFTC), 512};
            const BlDft bl{(const bf16_t*)(a.ws + WS_GTC) + (size_t)b * 512 * 256, 256, tn * 128};
            const EpPlain ep{(bf16_t*)(a.ws + WS_MIX), 1024, TLAT + b * 256, 768 + tn * 128};
            gemm_tile<256, 128, 4, 2, true>(lds, 512, al, bl, ep);
        }
    }
#endif
#ifndef NO_ATT
    const int nwu = 16384 + (l == 0 ? 2048 : 0);
    for (int wu = blockIdx.x * 8 + (otid() >> 6); wu < nwu; wu += G * 8) attn_wave(a, l, wu);
#endif
}

struct EpGlu { const bf16_t* yb; bf16_t* mix; const float* bg; int m0, n0;
    __device__ __forceinline__ void operator()(f32x4 (&acc)[4][4], int wm0, int wn0, int lane) const {
        const int fr = lane & 15, fq = lane >> 4;
#pragma unroll
        for (int mi = 0; mi < 4; ++mi)
#pragma unroll
            for (int ni = 0; ni < 4; ++ni) {
                const int m = m0 + wm0 + mi * 16 + fr, n = n0 + wn0 + ni * 16 + fq * 4;
                const u32x2 gw = *(const u32x2*)(yb + (size_t)m * 256 + n); const f32x4 bv = *(const f32x4*)(bg + n);
                const float g0 = __uint_as_float(gw.x << 16), g1 = __uint_as_float(gw.x & 0xffff0000u), g2 = __uint_as_float(gw.y << 16), g3 = __uint_as_float(gw.y & 0xffff0000u);
                u32x2 w; w.x = cvt_pk_bf16(g0 * sigmoidf_(acc[mi][ni][0] + bv[0]), g1 * sigmoidf_(acc[mi][ni][1] + bv[1]));
                w.y = cvt_pk_bf16(g2 * sigmoidf_(acc[mi][ni][2] + bv[2]), g3 * sigmoidf_(acc[mi][ni][3] + bv[3]));
                *(u32x2*)(mix + (size_t)m * 1024 + 512 + n) = w;
            }
    } };
__device__ void phase_glu(const Args& a, unsigned char* lds, int l, int M) {
    const bf16_t* yb = (const bf16_t*)(a.ws + WS_YB);
    for (int u = blockIdx.x; u < (M / 256) * 2; u += gridDim.x) {
        const int m0 = (u >> 1) * 256, n0 = (u & 1) * 128;
        const AlRow al{yb + (size_t)m0 * 256, 256}, bl{(const bf16_t*)(a.ws + WS_WGLU) + (size_t)l * 65536 + (size_t)n0 * 256, 256};
        const EpGlu ep{yb, (bf16_t*)(a.ws + WS_MIX), a.in[21] + l * 256, m0, n0};
        gemm_tile<256, 128, 4, 2, true>(lds, 256, al, bl, ep);
    }
}

struct EpRes { const Args* a; const float* mod2; int l, m0, n0;
    __device__ __forceinline__ void operator()(f32x4 (&acc)[4][4], int wm0, int wn0, int lane) const {
        const int fr = lane & 15, fq = lane >> 4;
#pragma unroll
        for (int mi = 0; mi < 4; ++mi) {
            const int m = m0 + wm0 + mi * 16 + fr;
            const float* xi = (l == 0) ? input_row(*a, m) : stream_row(*a, m);
            float* xo = stream_row(*a, m);
            const float* mr = mod2 + (size_t)row_batch(m) * 6144;
#pragma unroll
            for (int ni = 0; ni < 4; ++ni) { const int n = n0 + wn0 + ni * 16 + fq * 4;
                const f32x4 xv = *(const f32x4*)(xi + n), gv = *(const f32x4*)(mr + n);
                *(f32x4*)(xo + n) = xv + gv * acc[mi][ni]; }
        }
    } };
__device__ void phase_wout(const Args& a, unsigned char* lds, int l, int M) {
    const bf16_t* mix = (const bf16_t*)(a.ws + WS_MIX);
    const bf16_t* wt = (const bf16_t*)(a.ws + WS_WOUT) + (size_t)l * 1024 * 1024;
    const float* mod2 = (const float*)(a.ws + WS_MOD) + (size_t)l * 17 * 6144 + 2 * 1024;
    for (int u = blockIdx.x; u < (M / 256) * 8; u += gridDim.x) {
        const int m0 = (u >> 3) * 256, n0 = (u & 7) * 128;
        const AlRow al{mix + (size_t)m0 * 1024, 1024}, bl{wt + (size_t)n0 * 1024, 1024};
        const EpRes ep{&a, mod2, l, m0, n0};
        gemm_tile<256, 128, 4, 2, true>(lds, 1024, al, bl, ep);
    }
}

__device__ __forceinline__ int pair_id(int lo, int hi) { return lo == 0 ? hi - 1 : (lo == 1 ? hi + 1 : 5); }
__device__ void phase_norm2(const Args& a, unsigned char* lds, int l, int M) {
    const int tid = otid(), lane = tid & 63, wid = tid >> 6;
    float* wr = (float*)lds;
    int* rcls = (int*)(wr + 16 * 1024);
    float2* rw = (float2*)(rcls + 160);
    int* rrank = (int*)(rw + 160);
    int* cbase = rrank + 160;
    int* ccnt = cbase + 32;
    for (int i = tid; i < 16 * 1024; i += NTHR) { const int e = i >> 10, k = i & 1023; wr[i] = a.in[24][k * 16 + e]; }
    __syncthreads();
    const int rpb_ = M / gridDim.x;
    const int row0 = blockIdx.x * rpb_;
    const float* g2 = a.in[7] + l * 1024;
    const float* mod = (const float*)(a.ws + WS_MOD) + (size_t)l * 17 * 6144;
    bf16_t* hb = (bf16_t*)(a.ws + WS_HBUF);
    float br[16];
#pragma unroll
    for (int e = 0; e < 16; ++e) br[e] = a.in[25][e];
    for (int lr = wid; lr < rpb_; lr += 8) {
        const int m = row0 + lr;
        const float* xr = stream_row(a, m);
        const float* mr = mod + (size_t)row_batch(m) * 6144;
        f32x4 v[4]; float ss = 0.f;
#pragma unroll
        for (int i = 0; i < 4; ++i) { v[i] = *(const f32x4*)(xr + i * 256 + lane * 4); ss += v[i][0] * v[i][0] + v[i][1] * v[i][1] + v[i][2] * v[i][2] + v[i][3] * v[i][3]; }
        ss = wave_sum(ss);
        const float rstd = rsqrtf(ss * (1.0f / 1024.0f) + 1e-6f);
        float lg[16];
#pragma unroll
        for (int e = 0; e < 16; ++e) lg[e] = 0.f;
#pragma unroll
        for (int i = 0; i < 4; ++i) {
            const int c = i * 256 + lane * 4;
            const f32x4 g = *(const f32x4*)(g2 + c), sh = *(const f32x4*)(mr + 3 * 1024 + c), sc = *(const f32x4*)(mr + 4 * 1024 + c);
            f32x4 o;
#pragma unroll
            for (int j = 0; j < 4; ++j) o[j] = v[i][j] * rstd * g[j] * (1.0f + sc[j]) + sh[j];
            u32x2 w; w.x = cvt_pk_bf16(o[0], o[1]); w.y = cvt_pk_bf16(o[2], o[3]);
            *(u32x2*)(hb + (size_t)m * 1024 + c) = w;
#pragma unroll
            for (int e = 0; e < 16; ++e) { const f32x4 wv = *(const f32x4*)(wr + e * 1024 + c); lg[e] += o[0] * wv[0] + o[1] * wv[1] + o[2] * wv[2] + o[3] * wv[3]; }
        }
#pragma unroll
        for (int e = 0; e < 16; ++e) lg[e] = wave_sum(lg[e]);
        float aff[16], sel[16];
#pragma unroll
        for (int e = 0; e < 16; ++e) { aff[e] = sigmoidf_(lg[e]); sel[e] = aff[e] + br[e]; }
        int bg = 0, blo = 0, bhi = 1; float bscore = -1e30f, bwlo = 0.f, bwhi = 0.f;
#pragma unroll
        for (int g = 0; g < 4; ++g) {
            int i1 = 0; float v1 = sel[g * 4];
#pragma unroll
            for (int j = 1; j < 4; ++j) if (sel[g * 4 + j] > v1) { v1 = sel[g * 4 + j]; i1 = j; }
            int i2 = -1; float v2 = -1e30f;
#pragma unroll
            for (int j = 0; j < 4; ++j) if (j != i1 && sel[g * 4 + j] > v2) { v2 = sel[g * 4 + j]; i2 = j; }
            const float sc = v1 + v2;
            if (sc > bscore) { bscore = sc; bg = g; blo = min(i1, i2); bhi = max(i1, i2);
                float a1 = 0.f, a2 = 0.f;
#pragma unroll
                for (int j = 0; j < 4; ++j) { if (j == blo) a1 = aff[g * 4 + j]; if (j == bhi) a2 = aff[g * 4 + j]; }
                bwlo = a1 / (a1 + a2); bwhi = a2 / (a1 + a2); }
        }
        if (lane == 0) { rcls[lr] = bg * 6 + pair_id(blo, bhi); rw[lr] = make_float2(bwlo, bwhi); }
    }
    __syncthreads();
    if (tid < NCLS) { int n = 0; for (int i = 0; i < rpb_; ++i) if (rcls[i] == tid) { rrank[i] = n; ++n; } ccnt[tid] = n;
        cbase[tid] = n > 0 ? (int)atomicAdd((unsigned*)(a.ws + WS_CTL) + 4096 + l * 32 + tid, (unsigned)n) : 0; }
    __syncthreads();
    int* perm = (int*)(a.ws + WS_PERM); float2* tokw = (float2*)(a.ws + WS_TOKW);
    for (int i = tid; i < rpb_; i += NTHR) { const int c = rcls[i]; perm[(size_t)c * TT + cbase[c] + rrank[i]] = row0 + i; tokw[row0 + i] = rw[i]; }
    __syncthreads();
}

struct MoeTiles { int tile0[NCLS + 1]; int cnt[NCLS]; };
__device__ __forceinline__ void moe_tiles(const Args& a, int l, int* sh  ) {
    if (otid() == 0) { int t = 0; for (int c = 0; c < NCLS; ++c) { const int n = (int)__hip_atomic_load((unsigned*)(a.ws + WS_CTL) + 4096 + l * 32 + c, __ATOMIC_RELAXED, __HIP_MEMORY_SCOPE_AGENT); sh[c] = t; sh[32 + c] = n; t += (n + 255) >> 8; } sh[NCLS] = t; }
    __syncthreads();
}
__device__ __forceinline__ void class_experts(int c, int& e_lo, int& e_hi) { const int g = c / 6, p = c % 6; const int lo = p < 3 ? 0 : (p < 5 ? 1 : 2); const int hi = p < 3 ? p + 1 : (p < 5 ? p - 1 : 3); e_lo = g * 4 + lo; e_hi = g * 4 + hi; }

struct AlGather { const bf16_t* hb; const int* perm; int cnt, r0;
    __device__ __forceinline__ const bf16_t* operator()(int m, int k) const { const int r = min(r0 + m, cnt - 1); return hb + (size_t)perm[r] * 1024 + k; } };
struct BlGateUp { const bf16_t* wg; long long du; int hc0;
    __device__ __forceinline__ const bf16_t* operator()(int j, int k) const { const int jj = j & 63, hc = hc0 + (j >> 6) * 32 + (jj & 31); return wg + ((jj < 32 ? 0ll : du) + (long long)hc * 1024 + k); } };
struct EpGateUp { bf16_t* hm; const int* perm; const float2* tokw; int cnt, r0, rowbase, slot, hc0;
    __device__ __forceinline__ void operator()(f32x4 (&acc)[4][4], int wm0, int wn0, int lane) const {
        const int fr = lane & 15, fq = lane >> 4;
#pragma unroll
        for (int mi = 0; mi < 4; ++mi) {
            const int r = r0 + wm0 + mi * 16 + fr;
            if (r < cnt) {
                const float2 w2 = tokw[perm[r]]; const float w = slot == 0 ? w2.x : w2.y;
#pragma unroll
                for (int ni = 0; ni < 2; ++ni) {
                    float hv[4];
#pragma unroll
                    for (int j = 0; j < 4; ++j) hv[j] = siluf_(acc[mi][ni][j]) * acc[mi][ni + 2][j] * w;
                    u32x2 o; o.x = cvt_pk_bf16(hv[0], hv[1]); o.y = cvt_pk_bf16(hv[2], hv[3]);
                    *(u32x2*)(hm + (size_t)(rowbase + r) * 1024 + slot * 512 + hc0 + (wn0 >> 1) + ni * 16 + fq * 4) = o;
                }
            }
        }
    } };
__device__ void phase_moe_up(const Args& a, unsigned char* lds, int l) {
    int* sh = (int*)(lds + 120 * 1024);
    moe_tiles(a, l, sh);
    const int ntile = sh[NCLS];
    const bf16_t* hb = (const bf16_t*)(a.ws + WS_HBUF);
    for (int u = blockIdx.x; u < ntile * 16; u += gridDim.x) {
        const int tile = u >> 4, nt = u & 15;
        int c = 0; while (c + 1 < NCLS && sh[c + 1] <= tile) ++c;
        const int cnt = sh[32 + c], r0 = (tile - sh[c]) * 256, rowbase = sh[c] * 256;
        int e_lo, e_hi; class_experts(c, e_lo, e_hi);
        const int slot = nt >> 3, hc0 = (nt & 7) * 64, e = slot == 0 ? e_lo : e_hi;
        const int* perm = (const int*)(a.ws + WS_PERM) + (size_t)c * TT;
        const AlGather al{hb, perm, cnt, r0};
        const BlGateUp bl{(const bf16_t*)(a.ws + WS_WG) + ((size_t)l * 16 + e) * 512 * 1024, (long long)((WS_WU - WS_WG) / 2), hc0};
        const EpGateUp ep{(bf16_t*)(a.ws + WS_HMOE), perm, (const float2*)(a.ws + WS_TOKW), cnt, r0, rowbase, slot, hc0};
        gemm_tile<256, 128, 4, 2, true>(lds, 1024, al, bl, ep);
    }
}
struct BlDown { const bf16_t* w0; long long d1; int n0;
    __device__ __forceinline__ const bf16_t* operator()(int nl, int k) const { return w0 + ((k < 512 ? 0ll : d1) + (long long)(n0 + nl) * 512 + (k & 511)); } };
struct EpDown { const Args* a; const int* perm; const float* mod5; int cnt, r0, n0;
    __device__ __forceinline__ void operator()(f32x4 (&acc)[4][4], int wm0, int wn0, int lane) const {
        const int fr = lane & 15, fq = lane >> 4;
#pragma unroll
        for (int mi = 0; mi < 4; ++mi) {
            const int r = r0 + wm0 + mi * 16 + fr;
            if (r < cnt) {
                const int m = perm[r];
                float* xo = stream_row(*a, m);
                const float* mr = mod5 + (size_t)row_batch(m) * 6144;
#pragma unroll
                for (int ni = 0; ni < 4; ++ni) { const int n = n0 + wn0 + ni * 16 + fq * 4;
                    const f32x4 xv = *(const f32x4*)(xo + n), gv = *(const f32x4*)(mr + n);
                    *(f32x4*)(xo + n) = xv + gv * acc[mi][ni]; }
            }
        }
    } };
__device__ void phase_moe_down(const Args& a, unsigned char* lds, int l) {
    int* sh = (int*)(lds + 120 * 1024);
    moe_tiles(a, l, sh);
    const int ntile = sh[NCLS];
    const bf16_t* hm = (const bf16_t*)(a.ws + WS_HMOE);
    const float* mod5 = (const float*)(a.ws + WS_MOD) + (size_t)l * 17 * 6144 + 5 * 1024;
    for (int u = blockIdx.x; u < ntile * 8; u += gridDim.x) {
        const int tile = u >> 3, nt = u & 7;
        int c = 0; while (c + 1 < NCLS && sh[c + 1] <= tile) ++c;
        const int cnt = sh[32 + c], r0 = (tile - sh[c]) * 256, rowbase = sh[c] * 256;
        int e_lo, e_hi; class_experts(c, e_lo, e_hi);
        const AlRow al{hm + (size_t)(rowbase + r0) * 1024, 1024};
        const BlDown bl{(const bf16_t*)(a.ws + WS_WD) + ((size_t)l * 16 + e_lo) * 1024 * 512, (long long)(e_hi - e_lo) * 1024 * 512, nt * 128};
        const EpDown ep{&a, (const int*)(a.ws + WS_PERM) + (size_t)c * TT, mod5, cnt, r0, nt * 128};
        gemm_tile<256, 128, 4, 2, true>(lds, 1024, al, bl, ep);
    }
}

constexpr int LDS_BYTES = 128 * 1024;
constexpr int NPHASE = 17;
#ifndef PHSEL
#define PHSEL 0x1ff
#endif
#define PHASE(kind, idx, body) do { if (((PHSEL >> (kind)) & 1) && a.ph_lo <= (idx) && (idx) < a.ph_hi) { body; } if (a.ph_lo <= (idx) && (idx) + 1 < a.ph_hi) xcd_barrier(bar); } while (0)

__global__ void __launch_bounds__(NTHR, 2) fwd(Args a) {
    extern __shared__ __attribute__((aligned(16))) unsigned char smem[];
    unsigned char* lds = smem + 16;
    if (threadIdx.x == 0) *(uint4*)smem = make_uint4(0u, 0u, 0u, 0u);
    __syncthreads();
    XcdBarrier bar = xcd_barrier_post((unsigned*)(a.ws + WS_CTL), (volatile LAS unsigned*)smem);
    PHASE(0, 0, phase_prologue(a, lds));
    for (int l = 0; l < 2; ++l) {
        const int M = l == 0 ? TT : TLAT;
        const int p = 1 + 8 * l;
        PHASE(1, p + 0, phase_norm1(a, l));
        PHASE(2, p + 1, phase_win(a, lds, l));
        PHASE(3, p + 2, phase_mixers(a, lds, l));
        PHASE(4, p + 3, phase_glu(a, lds, l, M));
        PHASE(5, p + 4, phase_wout(a, lds, l, M));
        PHASE(6, p + 5, phase_norm2(a, lds, l, M));
        PHASE(7, p + 6, phase_moe_up(a, lds, l));
        PHASE(8, p + 7, phase_moe_down(a, lds, l));
    }
}

#ifndef N_LAUNCHES
#define N_LAUNCHES 1
#endif

extern "C" void kernel_launch(void* const* d_in, const int* in_sizes, int n_in, void* d_out, int out_size, void* d_ws, size_t ws_size, hipStream_t stream) {
    static int grid = 0;
    if (grid == 0) {
        if (n_in != 29 || out_size != TLAT * DM || ws_size < WS_END) { fprintf(stderr, "kernel_launch: unexpected shapes (n_in %d out %d ws %zu need %zu)\n", n_in, out_size, ws_size, (size_t)WS_END); grid = -1; return; }
        int dev = 0, cus = 0, per_cu = 0;
        if (hipGetDevice(&dev) != hipSuccess || hipDeviceGetAttribute(&cus, hipDeviceAttributeMultiprocessorCount, dev) != hipSuccess) { grid = -1; return; }
        if (hipFuncSetAttribute((const void*)fwd, hipFuncAttributeMaxDynamicSharedMemorySize, LDS_BYTES + 16) != hipSuccess) { fprintf(stderr, "kernel_launch: hipFuncSetAttribute failed\n"); grid = -1; return; }
        if (hipOccupancyMaxActiveBlocksPerMultiprocessor(&per_cu, (const void*)fwd, NTHR, LDS_BYTES + 16) != hipSuccess || per_cu < 1) fprintf(stderr, "kernel_launch: occupancy query says %d\n", per_cu);
        (void)hipGetLastError();
        grid = cus;
        if (grid != 256) { fprintf(stderr, "kernel_launch: built for 256 CUs, device has %d\n", cus); if (grid > 256 || TT % grid || TLAT % grid) { grid = -1; return; } }
    }
    if (grid < 0) return;
    (void)hipMemsetAsync((char*)d_ws + WS_CTL, 0, CTL_BYTES, stream);
    Args a{};
    for (int i = 0; i < 29; ++i) a.in[i] = (const float*)d_in[i];
    a.out = (float*)d_out; a.ws = (unsigned char*)d_ws;
    if (N_LAUNCHES == 1) { a.ph_lo = 0; a.ph_hi = NPHASE; hipLaunchKernelGGL(fwd, dim3(grid), dim3(NTHR), LDS_BYTES + 16, stream, a); }
    else for (int i = 0; i < NPHASE; ++i) { a.ph_lo = i; a.ph_hi = i + 1; hipLaunchKernelGGL(fwd, dim3(grid), dim3(NTHR), LDS_BYTES + 16, stream, a); }
}
```

```cpp
#include <hip/hip_runtime.h>
#include <cstdio>
#include <cstdint>

#define LAS __attribute__((address_space(3)))
typedef unsigned short bf16_t;
typedef short bf16x8 __attribute__((ext_vector_type(8)));
typedef float f32x4 __attribute__((ext_vector_type(4)));
typedef unsigned u32x2 __attribute__((ext_vector_type(2)));
typedef unsigned u32x4 __attribute__((ext_vector_type(4)));

constexpr int DM = 1024, NB = 16, SEQ = 2048, LC = 256, TLAT = NB * SEQ, TCTX = NB * LC, TT = TLAT + TCTX;
constexpr int NIN = 2304;
constexpr int NCLS = 24;
constexpr int NCH = 36;
constexpr int NTHR = 512;

constexpr size_t al256(size_t x) { return (x + 255) & ~(size_t)255; }
constexpr size_t WS_CTL = 0;
constexpr size_t CTL_BYTES = 65536;
constexpr size_t WS_MOD = WS_CTL + CTL_BYTES;
constexpr size_t WS_ROPE = al256(WS_MOD + (size_t)2 * 17 * 6144 * 4);
constexpr size_t WS_WIN = al256(WS_ROPE + (size_t)2 * 2048 * 32 * 4);
constexpr size_t WS_WOUT = al256(WS_WIN + (size_t)2 * NIN * 1024 * 2);
constexpr size_t WS_WGLU = al256(WS_WOUT + (size_t)2 * 1024 * 1024 * 2);
constexpr size_t WS_WG = al256(WS_WGLU + (size_t)2 * 256 * 256 * 2);
constexpr size_t WS_WU = al256(WS_WG + (size_t)2 * 16 * 512 * 1024 * 2);
constexpr size_t WS_WD = al256(WS_WU + (size_t)2 * 16 * 512 * 1024 * 2);
constexpr size_t WS_DFTL = al256(WS_WD + (size_t)2 * 16 * 1024 * 512 * 2);
constexpr size_t WS_DFTC = al256(WS_DFTL + (size_t)2048 * 4096 * 2);
constexpr size_t WS_PM = al256(WS_DFTC + (size_t)256 * 512 * 2);
constexpr size_t WS_KC = al256(WS_PM + (size_t)2 * 16 * 256 * 1024 * 2);
constexpr size_t WS_QT = al256(WS_KC + (size_t)2 * 16 * 128 * 256 * 2);
constexpr size_t WS_LAM64 = al256(WS_QT + (size_t)2 * 16 * 1024 * 256 * 2);
constexpr size_t WS_XC = al256(WS_LAM64 + (size_t)2 * 16 * 2 * 64 * 2 * 4);
constexpr size_t WS_HBUF = al256(WS_XC + (size_t)TCTX * 1024 * 4);
constexpr size_t WS_YB = WS_HBUF;
constexpr size_t WS_RB = al256(WS_HBUF + (size_t)TT * 1024 * 2);
constexpr size_t WS_Q = WS_RB;
constexpr size_t WS_K = al256(WS_Q + (size_t)TT * 512 * 2);
constexpr size_t WS_VTL = al256(WS_K + (size_t)TT * 512 * 2);
constexpr size_t WS_VTC = al256(WS_VTL + (size_t)16 * 512 * 2048 * 2);
constexpr size_t WS_US = al256(WS_VTC + (size_t)16 * 512 * 256 * 2);
constexpr size_t WS_GTL = al256(WS_US + (size_t)TT * 256 * 2);
constexpr size_t WS_GTC = al256(WS_GTL + (size_t)16 * 512 * 2048 * 2);
constexpr size_t WS_HS = al256(WS_GTC + (size_t)16 * 512 * 256 * 2);
constexpr size_t WS_RB_END = al256(WS_HS + (size_t)256 * 64 * 256 * 2);
constexpr size_t WS_HMOE = WS_RB;
static_assert(WS_RB + (size_t)(TT + NCLS * 256) * 1024 * 2 <= WS_RB_END, "HMOE must fit region B");
constexpr size_t WS_MIX = WS_RB_END;
constexpr size_t WS_PERM = al256(WS_MIX + (size_t)TT * 1024 * 2);
constexpr size_t WS_TOKW = al256(WS_PERM + (size_t)NCLS * TT * 4);
constexpr size_t WS_END = al256(WS_TOKW + (size_t)TT * 8);
static_assert(WS_END <= (size_t)512 * 1024 * 1024, "workspace map exceeds 512 MiB");

#define XB_TMO      128
#define XB_XCNT(j)  (256  + 64 * (j))
#define XB_XSUB(j)  (1280 + 64 * (j))
#define XB_XGEN(j)  (2304 + 64 * (j))
#define XB_TOP      3328
#define XB_TOPGEN   3392
#define XCD_BAR_WORDS 3456
#define XB_SPIN_CAP (1u << 18)
__device__ __forceinline__ unsigned xb_ld(unsigned* p)              { return __hip_atomic_load(p, __ATOMIC_RELAXED, __HIP_MEMORY_SCOPE_AGENT); }
__device__ __forceinline__ unsigned xb_add(unsigned* p, unsigned v) { return __hip_atomic_fetch_add(p, v, __ATOMIC_RELAXED, __HIP_MEMORY_SCOPE_AGENT); }
__device__ __forceinline__ unsigned xb_xcc_id() { return (unsigned)__builtin_amdgcn_s_getreg((3 << 11) | 20) & 0xFu; }
#define XB_SPIN(cond, bar) do { unsigned _sp = 0; while (cond) { __builtin_amdgcn_s_sleep(1); \
    if ((++_sp & 255u) == 0u) { if (xb_ld(&(bar)[XB_TMO])) break; if (_sp > XB_SPIN_CAP) { atomicAdd(&(bar)[XB_TMO], 1u); break; } } } } while (0)
struct XcdBarrier { unsigned* bar; unsigned x; volatile LAS unsigned* st; };
__device__ __forceinline__ XcdBarrier xcd_barrier_post(unsigned* bar, volatile LAS unsigned* st) {
    XcdBarrier b; b.bar = bar; b.x = xb_xcc_id(); b.st = st;
    if (threadIdx.x == 0) (void)xb_add(&bar[XB_XCNT(b.x)], 1u);
    return b;
}
__device__ __forceinline__ void xcd_barrier_complete(unsigned* bar, unsigned x, unsigned& nloc, unsigned& nx) {
    const unsigned G = gridDim.x * gridDim.y * gridDim.z;
    unsigned sum, cnt, mine, sp = 0u;
    for (;;) {
        sum = 0u; cnt = 0u; mine = 0u;
#pragma unroll
        for (unsigned j = 0; j < 16; ++j) { const unsigned c = xb_ld(&bar[XB_XCNT(j)]); sum += c; cnt += (c > 0u) ? 1u : 0u; mine = (j == x) ? c : mine; }
        if (sum == G) break;
        __builtin_amdgcn_s_sleep(1);
        if ((++sp & 255u) == 0u) { if (xb_ld(&bar[XB_TMO])) break; if (sp > XB_SPIN_CAP) { atomicAdd(&bar[XB_TMO], 1u); break; } }
    }
    nloc = mine > 0u ? mine : 1u; nx = cnt > 0u ? cnt : 1u;
}
__device__ __forceinline__ void xcd_barrier(const XcdBarrier& b) {
    asm volatile("s_waitcnt vmcnt(0)" ::: "memory");
    __syncthreads();
    if (threadIdx.x == 0) {
        unsigned* bar = b.bar;
        __builtin_amdgcn_s_waitcnt(0);
        unsigned nloc = b.st[0], nx = b.st[1];
        if (nloc == 0u) { xcd_barrier_complete(bar, b.x, nloc, nx); b.st[0] = nloc; b.st[1] = nx; }
        const unsigned old = xb_add(&bar[XB_XSUB(b.x)], 1u);
        const unsigned gen = old / nloc;
        if (old + 1u == (gen + 1u) * nloc) {
            __builtin_amdgcn_fence(__ATOMIC_RELEASE, "agent");
            asm volatile("s_waitcnt vmcnt(0)" ::: "memory");
            const unsigned og = xb_add(&bar[XB_TOP], 1u);
            const unsigned tg = og / nx;
            if (og + 1u == (tg + 1u) * nx) xb_add(&bar[XB_TOPGEN], 1u);
            else XB_SPIN(xb_ld(&bar[XB_TOPGEN]) == tg, bar);
            __builtin_amdgcn_fence(__ATOMIC_ACQUIRE, "agent");
            xb_add(&bar[XB_XGEN(b.x)], 1u);
            asm volatile("s_waitcnt vmcnt(0)" ::: "memory");
        } else {
            XB_SPIN(xb_ld(&bar[XB_XGEN(b.x)]) == gen, bar);
            __builtin_amdgcn_fence(__ATOMIC_ACQUIRE, "agent");
            asm volatile("s_waitcnt vmcnt(0)" ::: "memory");
        }
    }
    __syncthreads();
}

__device__ __forceinline__ unsigned cvt_pk_bf16(float lo, float hi) { unsigned r; asm volatile("v_cvt_pk_bf16_f32 %0, %1, %2" : "=v"(r) : "v"(lo), "v"(hi)); return r; }
__device__ __forceinline__ bf16_t f2bf(float f) { return (bf16_t)(cvt_pk_bf16(f, 0.f) & 0xffffu); }
__device__ __forceinline__ float bf2f(bf16_t b) { return __uint_as_float(((unsigned)b) << 16); }
__device__ __forceinline__ float sigmoidf_(float x) { return 1.0f / (1.0f + __expf(-x)); }
__device__ __forceinline__ float siluf_(float x) { return x / (1.0f + __expf(-x)); }
__device__ __forceinline__ float gelu_tanh(float x) { const float z = 0.7978845608028654f * (x + 0.044715f * x * x * x); const float e = __expf(2.0f * z); return 0.5f * x * (2.0f - 2.0f / (e + 1.0f)); }
__device__ __forceinline__ float wave_sum(float v) {
#pragma unroll
    for (int o = 32; o > 0; o >>= 1) v += __shfl_xor(v, o);
    return v;
}

__device__ __forceinline__ int otid() { int t = threadIdx.x; asm volatile("" : "+v"(t)); return t; }

struct Args {
    const float* in[29];
    float* out;
    unsigned char* ws;
    int ph_lo, ph_hi;
};

__device__ __forceinline__ int row_batch(int m) { return m < TLAT ? (m >> 11) : 16; }
__device__ __forceinline__ float* stream_row(const Args& a, int m) { return m < TLAT ? a.out + (size_t)m * DM : (float*)(a.ws + WS_XC) + (size_t)(m - TLAT) * DM; }
__device__ __forceinline__ const float* input_row(const Args& a, int m) { return m < TLAT ? a.in[0] + (size_t)m * DM : a.in[2] + (size_t)(m - TLAT) * DM; }

constexpr int LDP = 72;
template <int BM, int BN> constexpr int gemm_lds_bytes() { return 2 * (BM + BN) * LDP * 2; }

template <int BM, int BN, int WM, int WN, bool TR, class AL, class BL, class EP>
__device__ __forceinline__ void gemm_tile(unsigned char* lds, const int K, const AL& al, const BL& bl, const EP& ep) {
    static_assert(WM * WN == 8, "8 waves");
    constexpr int WTM = BM / WM, WTN = BN / WN, MI = WTM / 16, NI = WTN / 16;
    constexpr int NA = (BM * 8 + NTHR - 1) / NTHR, NBc = (BN * 8 + NTHR - 1) / NTHR;
    const int tid = otid(), lane = tid & 63, wid = tid >> 6, wm = wid / WN, wn = wid % WN;
    bf16_t* As = (bf16_t*)lds;
    bf16_t* Bs = As + 2 * BM * LDP;
    bf16x8 ra[NA], rb[NBc];
    f32x4 acc[MI][NI];
#pragma unroll
    for (int i = 0; i < MI; ++i)
#pragma unroll
        for (int j = 0; j < NI; ++j) acc[i][j] = (f32x4){0.f, 0.f, 0.f, 0.f};
    auto gload = [&](int k0) {
#pragma unroll
        for (int i = 0; i < NA; ++i) { const int q = tid + i * NTHR; if (BM * 8 >= NTHR * (i + 1) || q < BM * 8) ra[i] = *(const bf16x8*)al(q >> 3, k0 + (q & 7) * 8); }
#pragma unroll
        for (int i = 0; i < NBc; ++i) { const int q = tid + i * NTHR; if (BN * 8 >= NTHR * (i + 1) || q < BN * 8) rb[i] = *(const bf16x8*)bl(q >> 3, k0 + (q & 7) * 8); }
    };
    auto lstore = [&](int buf) {
#pragma unroll
        for (int i = 0; i < NA; ++i) { const int q = tid + i * NTHR; if (BM * 8 >= NTHR * (i + 1) || q < BM * 8) *(bf16x8*)(As + (buf * BM + (q >> 3)) * LDP + (q & 7) * 8) = ra[i]; }
#pragma unroll
        for (int i = 0; i < NBc; ++i) { const int q = tid + i * NTHR; if (BN * 8 >= NTHR * (i + 1) || q < BN * 8) *(bf16x8*)(Bs + (buf * BN + (q >> 3)) * LDP + (q & 7) * 8) = rb[i]; }
    };
    const int nk = K / 64;
    gload(0); lstore(0); __syncthreads();
#pragma unroll 1
    for (int kt = 0; kt < nk; ++kt) {
        const int buf = kt & 1;
        if (kt + 1 < nk) gload((kt + 1) * 64);
        const bf16_t* Ab = As + (buf * BM + wm * WTM + (lane & 15)) * LDP + (lane >> 4) * 8;
        const bf16_t* Bb = Bs + (buf * BN + wn * WTN + (lane & 15)) * LDP + (lane >> 4) * 8;
#pragma unroll
        for (int ks = 0; ks < 2; ++ks) {
            bf16x8 af[MI], bfr[NI];
#pragma unroll
            for (int i = 0; i < MI; ++i) af[i] = *(const bf16x8*)(Ab + i * 16 * LDP + ks * 32);
#pragma unroll
            for (int j = 0; j < NI; ++j) bfr[j] = *(const bf16x8*)(Bb + j * 16 * LDP + ks * 32);
#pragma unroll
            for (int i = 0; i < MI; ++i)
#pragma unroll
                for (int j = 0; j < NI; ++j)
                    acc[i][j] = TR ? __builtin_amdgcn_mfma_f32_16x16x32_bf16(bfr[j], af[i], acc[i][j], 0, 0, 0)
                                   : __builtin_amdgcn_mfma_f32_16x16x32_bf16(af[i], bfr[j], acc[i][j], 0, 0, 0);
        }
        if (kt + 1 < nk) lstore(buf ^ 1);
        __syncthreads();
    }
    ep(acc, wm * WTM, wn * WTN, lane);
}

constexpr int HTB = 128 * 64 * 2;
__device__ __forceinline__ int lds_byte(int r, int c) { const int st = (r >> 4) * 2 + (c >> 5), rr = r & 15, cc = c & 31, ob = rr * 64 + cc * 2; return st * 1024 + (ob ^ (((ob >> 9) & 1) << 5)); }
__device__ __forceinline__ void stage_rc(int b, int& R, int& C) { const int st = b / 1024, sb = b % 1024, swz = sb ^ (((sb >> 9) & 1) << 5); R = (st >> 1) * 16 + swz / 64; C = (st & 1) * 32 + (swz % 64) / 2; }
__device__ __forceinline__ int bcol_of(int h, int R) { return 64 * (R >> 5) + 32 * h + (R & 31); }

template <bool TR, class KA, class KB, class EP>
__device__ __forceinline__ void gemm256(LAS unsigned char* lds, const unsigned char* wsb, const unsigned (&voA)[2][2], const unsigned (&voB)[2][2], const int nt, const KA& ka, const KB& kb, const EP& ep) {
    int tid = otid();
    int wid = __builtin_amdgcn_readfirstlane(tid >> 6), lane = tid & 63, wr = wid >> 2, wc = wid & 3, fr = lane & 15, fq = lane >> 4;
    const unsigned ldsw = (unsigned)wid * 1024u;
    const int aoff = lds_byte(wr * 64 + fr, fq * 8), boff = lds_byte(wc * 32 + fr, fq * 8);
#define G_SA(b, h) (((b) * 2 + (h)) * HTB)
#define G_SB(b, h) ((4 + (b) * 2 + (h)) * HTB)
#define G_STAGE(slot, vo, ko) do { const unsigned _ko = (ko); _Pragma("unroll") for (int _i = 0; _i < 2; ++_i) \
        __builtin_amdgcn_global_load_lds((const unsigned*)(wsb + (size_t)((vo)[_i] + _ko)), (LAS unsigned*)(lds + (slot) + ldsw + _i * 8192), 16, 0, 0); } while (0)
#define G_LDA(dst, b, h) do { _Pragma("unroll") for (int m = 0; m < 4; ++m) _Pragma("unroll") for (int k = 0; k < 2; ++k) dst[m][k] = *(const LAS bf16x8*)(lds + G_SA(b, h) + aoff + m * 2048 + k * 1024); } while (0)
#define G_LDB(dst, b, h) do { _Pragma("unroll") for (int n = 0; n < 2; ++n) _Pragma("unroll") for (int k = 0; k < 2; ++k) dst[n][k] = *(const LAS bf16x8*)(lds + G_SB(b, h) + boff + n * 2048 + k * 1024); } while (0)
#define G_MMA(ai, bj, At, Bt) do { __builtin_amdgcn_s_setprio(1); _Pragma("unroll") for (int m = 0; m < 4; ++m) _Pragma("unroll") for (int n = 0; n < 2; ++n) _Pragma("unroll") for (int k = 0; k < 2; ++k) \
        acc[ai][bj][m][n] = TR ? __builtin_amdgcn_mfma_f32_16x16x32_bf16(Bt[n][k], At[m][k], acc[ai][bj][m][n], 0, 0, 0) : __builtin_amdgcn_mfma_f32_16x16x32_bf16(At[m][k], Bt[n][k], acc[ai][bj][m][n], 0, 0, 0); \
        __builtin_amdgcn_s_setprio(0); } while (0)
#define G_WV(n) asm volatile("s_waitcnt vmcnt(" #n ")" ::: "memory")
#define G_WL(n) asm volatile("s_waitcnt lgkmcnt(" #n ")" ::: "memory")
#define G_BAR __builtin_amdgcn_s_barrier()
#define G_SCHED __builtin_amdgcn_sched_barrier(0)
    f32x4 acc[2][2][4][2];
#pragma unroll
    for (int a_ = 0; a_ < 2; ++a_)
#pragma unroll
        for (int b_ = 0; b_ < 2; ++b_)
#pragma unroll
            for (int m = 0; m < 4; ++m)
#pragma unroll
                for (int n = 0; n < 2; ++n) acc[a_][b_][m][n] = (f32x4){0.f, 0.f, 0.f, 0.f};
    bf16x8 At[4][2], B0[2][2], B1[2][2];
    G_STAGE(G_SB(0, 0), voB[0], kb(0)); G_STAGE(G_SA(0, 0), voA[0], ka(0)); G_STAGE(G_SB(0, 1), voB[1], kb(0)); G_STAGE(G_SA(0, 1), voA[1], ka(0));
    if (wr == 1) G_BAR;
    G_WV(4); G_BAR;
    G_STAGE(G_SB(1, 0), voB[0], kb(1)); G_STAGE(G_SA(1, 0), voA[0], ka(1)); G_STAGE(G_SB(1, 1), voB[1], kb(1));
    G_WV(6); G_BAR;
#pragma unroll 1
    for (int t = 0; t < nt - 2; t += 2) {
        G_LDB(B0, 0, 0); G_SCHED; G_LDA(At, 0, 0); G_STAGE(G_SA(1, 1), voA[1], ka(t + 1));
        G_WL(8); G_BAR; G_WL(0); G_MMA(0, 0, At, B0); G_BAR; G_SCHED;
        G_LDB(B1, 0, 1); G_STAGE(G_SB(0, 0), voB[0], kb(t + 2));
        G_BAR; G_WL(0); G_MMA(0, 1, At, B1); G_BAR;
        G_LDA(At, 0, 1); G_STAGE(G_SA(0, 0), voA[0], ka(t + 2));
        G_BAR; G_WL(0); G_MMA(1, 0, At, B0); G_BAR; G_SCHED;
        G_STAGE(G_SB(0, 1), voB[1], kb(t + 2));
        G_WV(6); G_BAR; G_MMA(1, 1, At, B1); G_BAR;
        G_LDB(B0, 1, 0); G_SCHED; G_LDA(At, 1, 0); G_STAGE(G_SA(0, 1), voA[1], ka(t + 2));
        G_WL(8); G_BAR; G_WL(0); G_MMA(0, 0, At, B0); G_BAR; G_SCHED;
        G_LDB(B1, 1, 1); G_STAGE(G_SB(1, 0), voB[0], kb(t + 3));
        G_BAR; G_WL(0); G_MMA(0, 1, At, B1); G_BAR;
        G_LDA(At, 1, 1); G_STAGE(G_SA(1, 0), voA[0], ka(t + 3));
        G_BAR; G_WL(0); G_MMA(1, 0, At, B0); G_BAR; G_SCHED;
        G_STAGE(G_SB(1, 1), voB[1], kb(t + 3));
        G_WV(6); G_BAR; G_MMA(1, 1, At, B1); G_BAR;
    }
    { G_LDB(B0, 0, 0); G_WV(0); G_LDA(At, 0, 0); G_STAGE(G_SA(1, 1), voA[1], ka(nt - 1));
      G_BAR; G_WL(0); G_MMA(0, 0, At, B0); G_BAR;
      G_LDB(B1, 0, 1); G_BAR; G_WL(0); G_MMA(0, 1, At, B1); G_BAR;
      G_LDA(At, 0, 1); G_WV(4); G_BAR; G_WL(0); G_MMA(1, 0, At, B0); G_MMA(1, 1, At, B1); G_BAR; }
    { G_LDB(B0, 1, 0); G_LDA(At, 1, 0); G_WV(2); G_BAR; G_WL(0); G_MMA(0, 0, At, B0); G_BAR;
      G_LDB(B1, 1, 1); G_WV(0); G_BAR; G_WL(0); G_MMA(0, 1, At, B1); G_BAR;
      G_LDA(At, 1, 1); G_BAR; G_WL(0); G_MMA(1, 0, At, B0); G_MMA(1, 1, At, B1); G_BAR; }
    if (wr == 0) G_BAR;
    int tz = otid(); wid = tz >> 6; lane = tz & 63; wr = wid >> 2; wc = wid & 3; fr = lane & 15; fq = lane >> 4;
    ep(acc, wr, wc, fr, fq);
#undef G_STAGE
#undef G_LDA
#undef G_LDB
#undef G_MMA
}
struct KLin { __device__ __forceinline__ unsigned operator()(int kt) const { return (unsigned)kt * 128u; } };
template <class FA, class FB> __device__ __forceinline__ void make_offsets(unsigned (&voA)[2][2], unsigned (&voB)[2][2], const FA& fa, const FB& fb) {
    const int tid = otid();
#pragma unroll
    for (int i = 0; i < 2; ++i) { int R, C; stage_rc(tid * 16 + i * 8192, R, C);
#pragma unroll
        for (int h = 0; h < 2; ++h) { voA[h][i] = fa(h * 128 + R) + (unsigned)C * 2u; voB[h][i] = fb(bcol_of(h, R)) + (unsigned)C * 2u; } }
}

__device__ void pro_mod(const Args& a, unsigned char* lds, int unit) {
    const int tid = otid(), lane = tid & 63, wid = tid >> 6;
    float* sl = (float*)lds;
    float* part = sl + 17 * 1024;
    for (int i = tid; i < 17 * 1024; i += NTHR) { const int r = i >> 10, k = i & 1023; const float v = r < 16 ? a.in[1][r * 1024 + k] : a.in[3][k]; sl[i] = siluf_(v); }
    __syncthreads();
    const int l = unit / 96, n = (unit % 96) * 64 + lane;
    const float* w = a.in[4] + (size_t)l * 1024 * 6144 + n;
    float acc[17];
#pragma unroll
    for (int r = 0; r < 17; ++r) acc[r] = 0.f;
    for (int k = wid * 128; k < wid * 128 + 128; ++k) {
        const float wv = w[(size_t)k * 6144];
#pragma unroll
        for (int r = 0; r < 17; ++r) acc[r] += sl[r * 1024 + k] * wv;
    }
#pragma unroll
    for (int r = 0; r < 17; ++r) part[(wid * 17 + r) * 64 + lane] = acc[r];
    __syncthreads();
    float* mod = (float*)(a.ws + WS_MOD);
    for (int i = tid; i < 17 * 64; i += NTHR) {
        const int r = i >> 6, c = i & 63; float s = 0.f;
#pragma unroll
        for (int w8 = 0; w8 < 8; ++w8) s += part[(w8 * 17 + r) * 64 + c];
        const int nn = (unit % 96) * 64 + c;
        mod[((size_t)l * 17 + r) * 6144 + nn] = s + a.in[5][l * 6144 + nn];
    }
    __syncthreads();
}
__device__ void pro_tr64(const float* src, int lds_src, bf16_t* dst, int ld_dst, int k0, int n0, unsigned char* lds) {
    float* t = (float*)lds;
    const int tid = otid();
#pragma unroll
    for (int i = 0; i < 8; ++i) { const int e = tid + i * NTHR, r = e >> 6, c = e & 63; t[r * 65 + c] = src[(size_t)(k0 + r) * lds_src + n0 + c]; }
    __syncthreads();
#pragma unroll
    for (int i = 0; i < 4; ++i) { const int e = tid + i * NTHR, n = e >> 5, kp = (e & 31) * 2;
        *(unsigned*)(dst + (size_t)(n0 + n) * ld_dst + k0 + kp) = cvt_pk_bf16(t[kp * 65 + n], t[(kp + 1) * 65 + n]); }
    __syncthreads();
}
__device__ void pro_fold(const Args& a, unsigned char* lds, int unit) {
    const int tid = otid(), lane = tid & 63, wid = tid >> 6;
    float* ct = (float*)lds; float* st = ct + 64;
    float* xs = st + 64 + wid * 192; float* as = xs + 64; float* ss = as + 64;
    if (tid < 64) { ct[tid] = cospif((float)tid / 32.0f); st[tid] = sinpif((float)tid / 32.0f); }
    __syncthreads();
    const int l = unit >> 7, kk = (unit & 127) * 8 + wid;
    bf16_t* wt = (bf16_t*)(a.ws + WS_WIN) + (size_t)l * NIN * 1024;
    for (int h = 0; h < 4; ++h) {
        xs[lane] = a.in[8][((size_t)l * 1024 + kk) * 2048 + 1792 + h * 64 + lane];
        __builtin_amdgcn_wave_barrier();
        float ac = 0.f, as_ = 0.f;
        for (int d = 0; d < 64; ++d) { const float x = xs[d]; const int j = (lane * d) & 63; ac += x * ct[j]; as_ += x * st[j]; }
        as[lane] = ac; ss[lane] = as_;
        __builtin_amdgcn_wave_barrier();
        const float* wf = a.in[22] + ((size_t)l * 4 + h) * 4096;
        float gc = 0.f, gs = 0.f;
        for (int k2 = 0; k2 < 64; ++k2) { const float w = wf[k2 * 64 + lane]; gc += as[k2] * w; gs += ss[k2] * w; }
        wt[(size_t)(1792 + h * 64 + lane) * 1024 + kk] = f2bf(gc);
        wt[(size_t)(2048 + h * 64 + lane) * 1024 + kk] = f2bf(gs);
        __builtin_amdgcn_wave_barrier();
    }
    __syncthreads();
}
__device__ void pro_dft(const Args& a, int unit) {
    const int tid = otid();
    if (unit < 2048) {
        bf16_t* d = (bf16_t*)(a.ws + WS_DFTL) + (size_t)unit * 4096;
        const float sc = 0.0027621358640099513f;
        for (int c = tid; c < 2048; c += NTHR) { const float x = (float)((unit * c) & 2047) * (1.0f / 1024.0f); d[c] = f2bf(cospif(x) * sc); d[2048 + c] = f2bf(-sinpif(x) * sc); }
    } else {
        const float sc = 0.0078125f;
        const int k1 = (unit - 2048) * 8 + (tid >> 6);
        bf16_t* d = (bf16_t*)(a.ws + WS_DFTC) + (size_t)k1 * 512;
        for (int c = tid & 63; c < 256; c += 64) { const float x = (float)((k1 * c) & 255) * (1.0f / 128.0f); d[c] = f2bf(cospif(x) * sc); d[256 + c] = f2bf(-sinpif(x) * sc); }
    }
}
__device__ void pro_rope(const Args& a, int unit) {
    float* rc = (float*)(a.ws + WS_ROPE); float* rs = rc + 2048 * 32;
    const int e = unit * NTHR + otid(), t = e >> 5, i = e & 31;
    const float pos = (float)(i < 16 ? (t >> 6) : (t & 63));
    const float invf = powf(100.0f, -(float)(i & 15) / 16.0f);
    float s, c; sincosf(pos * invf, &s, &c); rc[e] = c; rs[e] = s;
}
__device__ void pro_s5(const Args& a, unsigned char* lds, int unit) {
    const int tid = otid();
    const int l = unit >> 7, g = (unit >> 3) & 15, part = unit & 7;
    float2* lp = (float2*)lds;
    float2* bb = lp + 2 * 65 * 64;
    float2* cm = bb + 2 * 64 * 16;
    for (int i = tid; i < 2 * 65 * 64; i += NTHR) {
        const int d = i / (65 * 64), j = (i / 64) % 65, p = i & 63;
        const int pi = ((l * 2 + d) * 16 + g) * 64 + p;
        const float step = expf(a.in[14][(l * 2 + d) * 16 + g]);
        const float re = a.in[12][pi] * step * (float)j, im = a.in[13][pi] * step * (float)j;
        float s, c; sincosf(im, &s, &c); const float m = expf(re);
        lp[i] = make_float2(m * c, m * s);
    }
    __syncthreads();
    for (int i = tid; i < 2 * 64 * 16; i += NTHR) {
        const int d = i >> 10, p = (i >> 4) & 63, c = i & 15;
        const int pi = ((l * 2 + d) * 16 + g) * 64 + p;
        const float lr = a.in[12][pi], li = a.in[13][pi];
        const float2 lb = lp[(d * 65 + 1) * 64 + p];
        const float nr = lb.x - 1.0f, ni = lb.y, den = lr * lr + li * li;
        const float qr = (nr * lr + ni * li) / den, qi = (ni * lr - nr * li) / den;
        const float br = a.in[15][(size_t)pi * 16 + c], bi = a.in[16][(size_t)pi * 16 + c];
        bb[i] = make_float2(qr * br - qi * bi, qr * bi + qi * br);
    }
    for (int i = tid; i < 2 * 16 * 64; i += NTHR) {
        const int d = i >> 10, c = (i >> 6) & 15, p = i & 63;
        const size_t ci = ((((size_t)l * 2 + d) * 16 + g) * 16 + c) * 64 + p;
        cm[i] = make_float2(a.in[17][ci], a.in[18][ci]);
    }
    __syncthreads();
    const size_t lg = (size_t)l * 16 + g;
    { bf16_t* pm = (bf16_t*)(a.ws + WS_PM) + lg * 256 * 1024;
      for (int i = tid; i < 32 * 1024; i += NTHR) {
          const int n = part * 32 + (i >> 10), k = i & 1023, d = n >> 7, p = (n >> 1) & 63, ri = n & 1, s = k >> 4, c = k & 15;
          const float2 pw = lp[(d * 65 + (d == 0 ? 63 - s : s)) * 64 + p], b = bb[(d * 64 + p) * 16 + c];
          pm[(size_t)n * 1024 + k] = f2bf(ri == 0 ? pw.x * b.x - pw.y * b.y : pw.x * b.y + pw.y * b.x);
      } }
    { bf16_t* qt = (bf16_t*)(a.ws + WS_QT) + lg * 1024 * 256;
      for (int i = tid; i < 128 * 256; i += NTHR) {
          const int n = part * 128 + (i >> 8), k = i & 255, t = n >> 4, c = n & 15, d = k >> 7, p = (k >> 1) & 63, ri = k & 1;
          const float2 pw = lp[(d * 65 + (d == 0 ? t + 1 : 64 - t)) * 64 + p], cc = cm[(d * 16 + c) * 64 + p];
          qt[(size_t)n * 256 + k] = f2bf(ri == 0 ? cc.x * pw.x - cc.y * pw.y : -(cc.x * pw.y + cc.y * pw.x));
      } }
    { bf16_t* kc = (bf16_t*)(a.ws + WS_KC) + lg * 128 * 256;
      for (int i = tid; i < 16 * 256; i += NTHR) {
          const int jj = part * 16 + (i >> 8), c = (i >> 4) & 15, c2 = i & 15;
          float v = 0.f;
          if (jj <= 126) {
              const int j = jj - 63;
              if (j >= 0) { for (int p = 0; p < 64; ++p) { const float2 pw = lp[(0 * 65 + j) * 64 + p], b = bb[(0 * 64 + p) * 16 + c2], cc = cm[(0 * 16 + c) * 64 + p];
                      const float tr = pw.x * b.x - pw.y * b.y, ti = pw.x * b.y + pw.y * b.x; v += cc.x * tr - cc.y * ti; } }
              if (j <= 0) { for (int p = 0; p < 64; ++p) { const float2 pw = lp[(1 * 65 - j) * 64 + p], b = bb[(1 * 64 + p) * 16 + c2], cc = cm[(1 * 16 + c) * 64 + p];
                      const float tr = pw.x * b.x - pw.y * b.y, ti = pw.x * b.y + pw.y * b.x; v += cc.x * tr - cc.y * ti; } }
              if (j == 0 && c == c2) v += a.in[19][l * 256 + g * 16 + c];
          }
          kc[(size_t)jj * 256 + c * 16 + c2] = f2bf(v);
      } }
    if (part == 0 && tid < 128) { const int d = tid >> 6, p = tid & 63; const float2 v = lp[(d * 65 + 64) * 64 + p];
        float* o = (float*)(a.ws + WS_LAM64) + ((lg * 2 + d) * 64 + p) * 2; o[0] = v.x; o[1] = v.y; }
    __syncthreads();
}

__device__ void phase_prologue(const Args& a, unsigned char* lds) {
    const int G = gridDim.x;
    constexpr int U_MOD = 192, U_FOLD = 256, U_S5 = 256, U_DFT = 2048 + 32, U_ROPE = 128;
    constexpr int T_WIN = 2 * 16 * 28, T_WOUT = 2 * 16 * 16, T_WGLU = 2 * 4 * 4, T_WG = 32 * 16 * 8, T_WD = 32 * 8 * 16;
    constexpr int U_TOT = U_MOD + U_FOLD + U_S5 + U_DFT + U_ROPE + T_WIN + T_WOUT + T_WGLU + 2 * T_WG + T_WD;
    for (int u0 = blockIdx.x; u0 < U_TOT; u0 += G) {
        int u = u0;
        if (u < U_MOD) { pro_mod(a, lds, u); continue; } u -= U_MOD;
        if (u < U_FOLD) { pro_fold(a, lds, u); continue; } u -= U_FOLD;
        if (u < U_S5) { pro_s5(a, lds, u); continue; } u -= U_S5;
        if (u < U_DFT) { pro_dft(a, u); continue; } u -= U_DFT;
        if (u < U_ROPE) { pro_rope(a, u); continue; } u -= U_ROPE;
        if (u < T_WIN) { const int l = u / (16 * 28), r = u % (16 * 28);
            pro_tr64(a.in[8] + (size_t)l * 1024 * 2048, 2048, (bf16_t*)(a.ws + WS_WIN) + (size_t)l * NIN * 1024, 1024, (r / 28) * 64, (r % 28) * 64, lds); continue; } u -= T_WIN;
        if (u < T_WOUT) { const int l = u >> 8, r = u & 255;
            pro_tr64(a.in[23] + (size_t)l * 1024 * 1024, 1024, (bf16_t*)(a.ws + WS_WOUT) + (size_t)l * 1024 * 1024, 1024, (r >> 4) * 64, (r & 15) * 64, lds); continue; } u -= T_WOUT;
        if (u < T_WGLU) { const int l = u >> 4, r = u & 15;
            pro_tr64(a.in[20] + (size_t)l * 256 * 256, 256, (bf16_t*)(a.ws + WS_WGLU) + (size_t)l * 256 * 256, 256, (r >> 2) * 64, (r & 3) * 64, lds); continue; } u -= T_WGLU;
        if (u < 2 * T_WG) { const int which = u / T_WG, v = u % T_WG, le = v >> 7, r = v & 127;
            pro_tr64(a.in[26 + which] + (size_t)le * 1024 * 512, 512, (bf16_t*)(a.ws + (which ? WS_WU : WS_WG)) + (size_t)le * 512 * 1024, 1024, (r >> 3) * 64, (r & 7) * 64, lds); continue; } u -= 2 * T_WG;
        { const int le = u >> 7, r = u & 127;
            pro_tr64(a.in[28] + (size_t)le * 512 * 1024, 1024, (bf16_t*)(a.ws + WS_WD) + (size_t)le * 1024 * 512, 512, (r >> 4) * 64, (r & 15) * 64, lds); }
    }
}

__device__ void phase_norm1(const Args& a, int l) {
    const int lane = otid() & 63, gw = blockIdx.x * 8 + (otid() >> 6), nw = gridDim.x * 8;
    const float* g1 = a.in[6] + l * 1024;
    const float* mod = (const float*)(a.ws + WS_MOD) + (size_t)l * 17 * 6144;
    bf16_t* hb = (bf16_t*)(a.ws + WS_HBUF);
    for (int m = gw; m < TT; m += nw) {
        const float* xr = (l == 0) ? input_row(a, m) : stream_row(a, m);
        const float* mr = mod + (size_t)row_batch(m) * 6144;
        f32x4 v[4]; float ss = 0.f;
#pragma unroll
        for (int i = 0; i < 4; ++i) { v[i] = *(const f32x4*)(xr + i * 256 + lane * 4); ss += v[i][0] * v[i][0] + v[i][1] * v[i][1] + v[i][2] * v[i][2] + v[i][3] * v[i][3]; }
        ss = wave_sum(ss);
        const float rstd = rsqrtf(ss * (1.0f / 1024.0f) + 1e-6f);
#pragma unroll
        for (int i = 0; i < 4; ++i) {
            const int c = i * 256 + lane * 4;
            const f32x4 g = *(const f32x4*)(g1 + c), sh = *(const f32x4*)(mr + c), sc = *(const f32x4*)(mr + 1024 + c);
            float o[4];
#pragma unroll
            for (int j = 0; j < 4; ++j) o[j] = v[i][j] * rstd * g[j] * (1.0f + sc[j]) + sh[j];
            u32x2 w; w.x = cvt_pk_bf16(o[0], o[1]); w.y = cvt_pk_bf16(o[2], o[3]);
            *(u32x2*)(hb + (size_t)m * 1024 + c) = w;
        }
    }
}

struct AlRow { const bf16_t* base; int ld; __device__ __forceinline__ const bf16_t* operator()(int m, int k) const { return base + (size_t)m * ld + k; } };

struct EpQK {
    bf16_t* dst; const float* g; const float* rope; int m0, c0; bool latent;
    __device__ __forceinline__ void operator()(f32x4 (&acc)[4][4], int wm0, int wn0, int lane) const {
        const int fr = lane & 15, fq = lane >> 4;
        f32x4 gv[4];
#pragma unroll
        for (int ni = 0; ni < 4; ++ni) gv[ni] = *(const f32x4*)(g + ni * 16 + fq * 4);
#pragma unroll
        for (int mi = 0; mi < 4; ++mi) {
            const int m = m0 + wm0 + mi * 16 + fr;
            float ss = 0.f;
#pragma unroll
            for (int ni = 0; ni < 4; ++ni)
#pragma unroll
                for (int j = 0; j < 4; ++j) ss += acc[mi][ni][j] * acc[mi][ni][j];
            ss += __shfl_xor(ss, 16); ss += __shfl_xor(ss, 32);
            const float rstd = rsqrtf(ss * (1.0f / 64.0f) + 1e-6f);
            f32x4 y[4];
#pragma unroll
            for (int ni = 0; ni < 4; ++ni)
#pragma unroll
                for (int j = 0; j < 4; ++j) y[ni][j] = acc[mi][ni][j] * rstd * gv[ni][j];
            if (latent) {
                const int pos = m & 2047;
#pragma unroll
                for (int ni = 0; ni < 2; ++ni) {
                    const f32x4 cs = *(const f32x4*)(rope + pos * 32 + ni * 16 + fq * 4), sn = *(const f32x4*)(rope + 2048 * 32 + pos * 32 + ni * 16 + fq * 4);
#pragma unroll
                    for (int j = 0; j < 4; ++j) { const float x1 = y[ni][j], x2 = y[ni + 2][j]; y[ni][j] = x1 * cs[j] - x2 * sn[j]; y[ni + 2][j] = x1 * sn[j] + x2 * cs[j]; }
                }
            }
#pragma unroll
            for (int ni = 0; ni < 4; ++ni) { u32x2 w; w.x = cvt_pk_bf16(y[ni][0], y[ni][1]); w.y = cvt_pk_bf16(y[ni][2], y[ni][3]);
                *(u32x2*)(dst + (size_t)m * 512 + c0 + wn0 + ni * 16 + fq * 4) = w; }
        }
    }
};
struct EpPlain {
    bf16_t* dst; int ld, m0, c0;
    template <int MI, int NI> __device__ __forceinline__ void operator()(f32x4 (&acc)[MI][NI], int wm0, int wn0, int lane) const {
        const int fr = lane & 15, fq = lane >> 4;
#pragma unroll
        for (int mi = 0; mi < MI; ++mi)
#pragma unroll
            for (int ni = 0; ni < NI; ++ni) { u32x2 w; w.x = cvt_pk_bf16(acc[mi][ni][0], acc[mi][ni][1]); w.y = cvt_pk_bf16(acc[mi][ni][2], acc[mi][ni][3]);
                *(u32x2*)(dst + (size_t)(m0 + wm0 + mi * 16 + fr) * ld + c0 + wn0 + ni * 16 + fq * 4) = w; }
    }
};
struct EpTrans {
    bf16_t* dst; int ldt, l0, c0;
    template <int MI, int NI> __device__ __forceinline__ void operator()(f32x4 (&acc)[MI][NI], int wm0, int wn0, int lane) const {
        const int fr = lane & 15, fq = lane >> 4;
#pragma unroll
        for (int mi = 0; mi < MI; ++mi)
#pragma unroll
            for (int ni = 0; ni < NI; ++ni) { u32x2 w; w.x = cvt_pk_bf16(acc[mi][ni][0], acc[mi][ni][1]); w.y = cvt_pk_bf16(acc[mi][ni][2], acc[mi][ni][3]);
                *(u32x2*)(dst + (size_t)(c0 + wn0 + ni * 16 + fr) * ldt + l0 + wm0 + mi * 16 + fq * 4) = w; }
    }
};

typedef f32x4 Acc256[2][2][4][2];
struct EpQK2 {
    bf16_t* dst; const float* g; const float* rope; int m0, c0; bool latent;
    __device__ __forceinline__ void operator()(Acc256& acc, int wr, int wc, int fr, int fq) const {
        f32x4 gv[2][2];
#pragma unroll
        for (int bj = 0; bj < 2; ++bj)
#pragma unroll
            for (int n = 0; n < 2; ++n) gv[bj][n] = *(const f32x4*)(g + bj * 32 + n * 16 + fq * 4);
#pragma unroll
        for (int ai = 0; ai < 2; ++ai)
#pragma unroll
            for (int m = 0; m < 4; ++m) {
                const int row = m0 + ai * 128 + wr * 64 + m * 16 + fr;
                float ss = 0.f;
#pragma unroll
                for (int bj = 0; bj < 2; ++bj)
#pragma unroll
                    for (int n = 0; n < 2; ++n)
#pragma unroll
                        for (int j = 0; j < 4; ++j) ss += acc[ai][bj][m][n][j] * acc[ai][bj][m][n][j];
                ss += __shfl_xor(ss, 16); ss += __shfl_xor(ss, 32);
                const float rstd = rsqrtf(ss * (1.0f / 64.0f) + 1e-6f);
                f32x4 y[2][2];
#pragma unroll
                for (int bj = 0; bj < 2; ++bj)
#pragma unroll
                    for (int n = 0; n < 2; ++n)
#pragma unroll
                        for (int j = 0; j < 4; ++j) y[bj][n][j] = acc[ai][bj][m][n][j] * rstd * gv[bj][n][j];
                if (latent) {
                    const int pos = row & 2047;
#pragma unroll
                    for (int n = 0; n < 2; ++n) {
                        const f32x4 cs = *(const f32x4*)(rope + pos * 32 + n * 16 + fq * 4), sn = *(const f32x4*)(rope + 2048 * 32 + pos * 32 + n * 16 + fq * 4);
#pragma unroll
                        for (int j = 0; j < 4; ++j) { const float x1 = y[0][n][j], x2 = y[1][n][j]; y[0][n][j] = x1 * cs[j] - x2 * sn[j]; y[1][n][j] = x1 * sn[j] + x2 * cs[j]; }
                    }
                }
#pragma unroll
                for (int bj = 0; bj < 2; ++bj)
#pragma unroll
                    for (int n = 0; n < 2; ++n) { u32x2 w; w.x = cvt_pk_bf16(y[bj][n][0], y[bj][n][1]); w.y = cvt_pk_bf16(y[bj][n][2], y[bj][n][3]);
                        *(u32x2*)(dst + (size_t)row * 512 + c0 + wc * 64 + bj * 32 + n * 16 + fq * 4) = w; }
            }
    }
};
struct EpPlain2 {
    bf16_t* dst; int ld, m0, c0;
    __device__ __forceinline__ void operator()(Acc256& acc, int wr, int wc, int fr, int fq) const {
#pragma unroll
        for (int ai = 0; ai < 2; ++ai)
#pragma unroll
            for (int m = 0; m < 4; ++m)
#pragma unroll
                for (int bj = 0; bj < 2; ++bj)
#pragma unroll
                    for (int n = 0; n < 2; ++n) { u32x2 w; w.x = cvt_pk_bf16(acc[ai][bj][m][n][0], acc[ai][bj][m][n][1]); w.y = cvt_pk_bf16(acc[ai][bj][m][n][2], acc[ai][bj][m][n][3]);
                        *(u32x2*)(dst + (size_t)(m0 + ai * 128 + wr * 64 + m * 16 + fr) * ld + c0 + wc * 64 + bj * 32 + n * 16 + fq * 4) = w; }
    }
};
struct EpTrans2 {
    bf16_t* dst; int ldt, l0, c0;
    __device__ __forceinline__ void operator()(Acc256& acc, int wr, int wc, int fr, int fq) const {
#pragma unroll
        for (int ai = 0; ai < 2; ++ai)
#pragma unroll
            for (int m = 0; m < 4; ++m)
#pragma unroll
                for (int bj = 0; bj < 2; ++bj)
#pragma unroll
                    for (int n = 0; n < 2; ++n) { u32x2 w; w.x = cvt_pk_bf16(acc[ai][bj][m][n][0], acc[ai][bj][m][n][1]); w.y = cvt_pk_bf16(acc[ai][bj][m][n][2], acc[ai][bj][m][n][3]);
                        *(u32x2*)(dst + (size_t)(c0 + wc * 64 + bj * 32 + n * 16 + fr) * ldt + l0 + ai * 128 + wr * 64 + m * 16 + fq * 4) = w; }
    }
};

__device__ void phase_win(const Args& a, LAS unsigned char* lds, int l) {
    const int nu = 128 * 9 + 16 * (l == 0 ? 9 : 5);
    for (int u = blockIdx.x; u < nu; u += gridDim.x) {
        int tm, tn;
        if (u < 128 * 9) { tm = u / 9; tn = u % 9; } else if (l == 0) { const int v = u - 128 * 9; tm = 128 + v / 9; tn = v % 9; } else { const int v = u - 128 * 9; tm = 128 + v / 5; tn = 2 + v % 5; }
        const int m0 = tm * 256, n0 = tn * 256;
        const bool latent = m0 < TLAT;
        const int b = latent ? (m0 >> 11) : ((m0 - TLAT) >> 8);
        unsigned voA[2][2], voB[2][2];
        make_offsets(voA, voB, [&](int r) { return (unsigned)(WS_HBUF + (size_t)(m0 + r) * 2048); }, [&](int c) { return (unsigned)(WS_WIN + ((size_t)l * NIN + n0 + c) * 2048); });
        if (tn < 4) {
            const bool isq = tn < 2;
            const EpQK2 ep{(bf16_t*)(a.ws + (isq ? WS_Q : WS_K)), a.in[isq ? 9 : 10] + l * 64, (const float*)(a.ws + WS_ROPE), m0, n0 - (isq ? 0 : 512), latent};
            gemm256<true>(lds, a.ws, voA, voB, 16, KLin(), KLin(), ep);
        } else if (tn == 6) {
            const EpPlain2 ep{(bf16_t*)(a.ws + WS_US), 256, m0, 0};
            gemm256<true>(lds, a.ws, voA, voB, 16, KLin(), KLin(), ep);
        } else {
            const bool isv = tn < 6;
            bf16_t* dst = latent ? (bf16_t*)(a.ws + (isv ? WS_VTL : WS_GTL)) + (size_t)b * 512 * 2048 : (bf16_t*)(a.ws + (isv ? WS_VTC : WS_GTC)) + (size_t)b * 512 * 256;
            const EpTrans2 ep{dst, latent ? 2048 : 256, latent ? (m0 & 2047) : 0, n0 - (isv ? 1024 : 1792)};
            gemm256<false>(lds, a.ws, voA, voB, 16, KLin(), KLin(), ep);
        }
    }
}

struct AlS5 { const bf16_t* us; const bf16_t* hs; int b, g;
    __device__ __forceinline__ const bf16_t* operator()(int m, int k) const {
        if (k >= 1024) return hs + (size_t)m * 256 + (k - 1024);
        const int ch = m < NCH ? m : NCH - 1;
        const int tok0 = ch < 4 ? TLAT + b * 256 + ch * 64 : b * 2048 + (ch - 4) * 64;
        return us + (size_t)(tok0 + (k >> 4)) * 256 + g * 16 + (k & 15);
    } };
struct BlS5Y { const bf16_t* kc; const bf16_t* qt; int n0;
    __device__ __forceinline__ const bf16_t* operator()(int nl, int k) const {
        const int n = n0 + nl;
        if (k >= 1024) return qt + (size_t)n * 256 + (k - 1024);
        return kc + (((n >> 4) - (k >> 4) + 63) * 16 + (n & 15)) * 16 + (k & 15);
    } };
struct EpS5S { float* S;
    __device__ __forceinline__ void operator()(f32x4 (&acc)[2][4], int wm0, int wn0, int lane) const {
        const int fr = lane & 15, fq = lane >> 4;
#pragma unroll
        for (int mi = 0; mi < 2; ++mi)
#pragma unroll
            for (int ni = 0; ni < 4; ++ni) *(f32x4*)(S + (wm0 + mi * 16 + fr) * 256 + wn0 + ni * 16 + fq * 4) = acc[mi][ni];
    } };
struct EpS5Y { bf16_t* yb; int b, g, n0;
    __device__ __forceinline__ void operator()(f32x4 (&acc)[2][4], int wm0, int wn0, int lane) const {
        const int fr = lane & 15, fq = lane >> 4;
#pragma unroll
        for (int mi = 0; mi < 2; ++mi) {
            const int ch = wm0 + mi * 16 + fr;
            if (ch < NCH) {
                const int tok0 = ch < 4 ? TLAT + b * 256 + ch * 64 : b * 2048 + (ch - 4) * 64;
#pragma unroll
                for (int ni = 0; ni < 4; ++ni) { const int n = n0 + wn0 + ni * 16 + fq * 4;
                    u32x2 w; w.x = cvt_pk_bf16(gelu_tanh(acc[mi][ni][0]), gelu_tanh(acc[mi][ni][1])); w.y = cvt_pk_bf16(gelu_tanh(acc[mi][ni][2]), gelu_tanh(acc[mi][ni][3]));
                    *(u32x2*)(yb + (size_t)(tok0 + (n >> 4)) * 256 + g * 16 + (n & 15)) = w; }
            }
        }
    } };

__device__ void s5_unit(const Args& a, unsigned char* lds, int l, int unit) {
    const int b = unit >> 4, g = unit & 15, tid = otid();
    const size_t lg = (size_t)l * 16 + g;
    const bf16_t* us = (const bf16_t*)(a.ws + WS_US);
    bf16_t* hs = (bf16_t*)(a.ws + WS_HS) + (size_t)unit * 64 * 256;
    float* S = (float*)lds;
    {
        const AlS5 al{us, hs, b, g}; const AlRow bl{(const bf16_t*)(a.ws + WS_PM) + lg * 256 * 1024, 1024};
        const EpS5S ep{S};
        gemm_tile<64, 256, 2, 4, true>(lds, 1024, al, bl, ep);
    }
    __syncthreads();
    if (tid < 128) {
        const int d = tid >> 6, p = tid & 63;
        const float* lm = (const float*)(a.ws + WS_LAM64) + ((lg * 2 + d) * 64 + p) * 2;
        const float lr = lm[0], li = lm[1];
        float hr = 0.f, hi = 0.f;
#pragma unroll 1
        for (int i = 0; i < NCH; ++i) {
            const int ch = d == 0 ? i : (i < 4 ? 3 - i : NCH + 3 - i);
            *(unsigned*)(hs + (size_t)ch * 256 + d * 128 + p * 2) = cvt_pk_bf16(hr, hi);
            const float sr = S[ch * 256 + d * 128 + p * 2], si = S[ch * 256 + d * 128 + p * 2 + 1];
            const float nr = lr * hr - li * hi + sr, ni = lr * hi + li * hr + si;
            hr = nr; hi = ni;
        }
    }
    __syncthreads();
#pragma unroll 1
    for (int nt = 0; nt < 4; ++nt) {
        const AlS5 al{us, hs, b, g};
        const BlS5Y bl{(const bf16_t*)(a.ws + WS_KC) + lg * 128 * 256, (const bf16_t*)(a.ws + WS_QT) + lg * 1024 * 256, nt * 256};
        const EpS5Y ep{(bf16_t*)(a.ws + WS_YB), b, g, nt * 256};
        gemm_tile<64, 256, 2, 4, true>(lds, 1280, al, bl, ep);
    }
}

struct BlDft { const bf16_t* gt; int L, n0;
    __device__ __forceinline__ const bf16_t* operator()(int nl, int k) const { const int hi = k >= L; return gt + (size_t)((hi ? 256 : 0) + n0 + nl) * L + (k - (hi ? L : 0)); } };

constexpr int AT_VOFF = 5 * 64 * 144;
struct AChunk { int b, h, R_lo, c0, nr, isctx; };
struct AStep { int unit, ch; bool valid; };
__device__ __forceinline__ void at_chunk(const AStep& st, AChunk& c) {
    if (st.unit < 2048) { const int rp = st.unit & 15; c.h = (st.unit >> 4) & 7; c.b = st.unit >> 7; const int r0 = 2 * rp;
        c.R_lo = min(max(r0 - 4, 0), 24); const int nrows = min(max(r0 - 3, 0), 24) + 8 - c.R_lo;
        c.isctx = st.ch == 2; c.c0 = st.ch == 1 ? 5 : 0; c.nr = st.ch == 0 ? 5 : (st.ch == 1 ? nrows - 5 : 4); }
    else { const int v = st.unit - 2048; c.h = (v >> 1) & 7; c.b = v >> 4; c.R_lo = 0; c.c0 = 0; c.nr = 4; c.isctx = 1; }
}
__device__ __forceinline__ void at_next(AStep& st, int nunits) {
    if (st.ch < 2) { ++st.ch; return; }
    st.unit += 256; st.ch = st.unit < 2048 ? 0 : 2; st.valid = st.unit < nunits;
}
__device__ __forceinline__ void at_load(const Args& a, const AChunk& c, int tid, bf16x8 (&rk)[5], bf16x8 (&rv)[5]) {
    const bf16_t* Kb = (const bf16_t*)(a.ws + WS_K);
    const int col = tid >> 3, pc = tid & 7;
#pragma unroll
    for (int it = 0; it < 5; ++it) if (it < c.nr) {
        const int tok = c.isctx ? TLAT + c.b * 256 + it * 64 + col : c.b * 2048 + (c.R_lo + c.c0 + it) * 64 + col;
        rk[it] = *(const bf16x8*)(Kb + (size_t)tok * 512 + c.h * 64 + pc * 8);
        const bf16_t* vp = c.isctx ? (const bf16_t*)(a.ws + WS_VTC) + (size_t)(c.b * 512 + c.h * 64 + col) * 256 + it * 64 + pc * 8
                                   : (const bf16_t*)(a.ws + WS_VTL) + (size_t)(c.b * 512 + c.h * 64 + col) * 2048 + (c.R_lo + c.c0 + it) * 64 + pc * 8;
        rv[it] = *(const bf16x8*)vp;
    }
}
__device__ __forceinline__ void at_store(unsigned char* lds, const AChunk& c, int tid, const bf16x8 (&rk)[5], const bf16x8 (&rv)[5]) {
    const int col = tid >> 3, pc = tid & 7;
    const int slot = 32 * ((col & 7) >> 2) + 4 * (col >> 3) + (col & 3);
#pragma unroll
    for (int it = 0; it < 5; ++it) if (it < c.nr) {
        *(bf16x8*)(lds + (it * 64 + slot) * 144 + pc * 16) = rk[it];
        *(bf16x8*)(lds + AT_VOFF + col * 656 + it * 128 + pc * 16) = rv[it];
    }
}
struct AWave { bf16x8 qf[2]; f32x4 o[4]; float mrun, lrun; int r, mt, qrow0, rs, cb; };
template <bool LOC> __device__ __forceinline__ void at_scores(const unsigned char* lds, const AWave& w, int slot0, int fr, int fq, const float* rrow, int cs, int qc, f32x4 (&s)[2], float& mx) {
#pragma unroll
    for (int t = 0; t < 2; ++t) {
        f32x4 c = (f32x4){0.f, 0.f, 0.f, 0.f};
#pragma unroll
        for (int kd = 0; kd < 2; ++kd) {
            const bf16x8 kf = *(const bf16x8*)(lds + (slot0 + t * 32 + fr) * 144 + kd * 64 + fq * 16);
            c = __builtin_amdgcn_mfma_f32_16x16x32_bf16(kf, w.qf[kd], c, 0, 0, 0);
        }
#pragma unroll
        for (int j = 0; j < 4; ++j) {
            float v = c[j] * 0.125f;
            if (LOC) { const int kc = w.cb + 8 * fq + 4 * t + j; const bool ok = kc >= cs && kc < cs + 16; const int bidx = min(max(kc - qc + 15, 0), 30); v = ok ? v + rrow[bidx] : -1e30f; }
            c[j] = v; mx = fmaxf(mx, v);
        }
        s[t] = c;
    }
}
template <int NBLK> __device__ __forceinline__ void at_flash(AWave& w, f32x4 (&s)[NBLK][2], float mx, u32x4 (&pk)[NBLK]) {
    mx = fmaxf(mx, __shfl_xor(mx, 16)); mx = fmaxf(mx, __shfl_xor(mx, 32));
    const float mnew = fmaxf(w.mrun, mx), scale = __expf(w.mrun - mnew);
    w.mrun = mnew;
    float sum = 0.f;
#pragma unroll
    for (int bi = 0; bi < NBLK; ++bi) {
#pragma unroll
        for (int t = 0; t < 2; ++t)
#pragma unroll
            for (int j = 0; j < 4; ++j) { const float e = __expf(s[bi][t][j] - mnew); s[bi][t][j] = e; sum += e; }
        pk[bi].x = cvt_pk_bf16(s[bi][0][0], s[bi][0][1]); pk[bi].y = cvt_pk_bf16(s[bi][0][2], s[bi][0][3]);
        pk[bi].z = cvt_pk_bf16(s[bi][1][0], s[bi][1][1]); pk[bi].w = cvt_pk_bf16(s[bi][1][2], s[bi][1][3]);
    }
    sum += __shfl_xor(sum, 16); sum += __shfl_xor(sum, 32);
    w.lrun = w.lrun * scale + sum;
#pragma unroll
    for (int i = 0; i < 4; ++i) w.o[i] = w.o[i] * scale;
}
__device__ __forceinline__ void at_pv(const unsigned char* lds, AWave& w, const u32x4& pk, int keyoff, int fr, int fq) {
    bf16x8 pf; __builtin_memcpy(&pf, &pk, 16);
#pragma unroll
    for (int i = 0; i < 4; ++i) {
        const bf16x8 vf = *(const bf16x8*)(lds + AT_VOFF + (i * 16 + fr) * 656 + (keyoff + 8 * fq) * 2);
        w.o[i] = __builtin_amdgcn_mfma_f32_16x16x32_bf16(vf, pf, w.o[i], 0, 0, 0);
    }
}
__device__ void attn_phase(const Args& a, unsigned char* lds, int l) {
    const int tid = otid(), lane = tid & 63, wid = tid >> 6, fr = lane & 15, fq = lane >> 4;
    const int nunits = 2048 + (l == 0 ? 256 : 0);
    const bf16_t* Qb = (const bf16_t*)(a.ws + WS_Q);
    bf16_t* mix = (bf16_t*)(a.ws + WS_MIX);
    AStep st; { const int bx = blockIdx.x; st.unit = ((bx & 7) * 16 + (bx >> 7)) * 16 + ((bx >> 3) & 15); st.ch = 0; st.valid = true; }
    int round = 0;
    auto unit_of = [&](int rnd) { const int bx = blockIdx.x; return rnd < 8 ? ((bx & 7) * 16 + rnd * 2 + (bx >> 7)) * 16 + ((bx >> 3) & 15) : 2048 + bx; };
    st.unit = unit_of(0);
    bf16x8 rk[5], rv[5];
    AChunk cc; at_chunk(st, cc);
    at_load(a, cc, tid, rk, rv);
    AWave w;
    while (st.valid) {
        __syncthreads();
        at_store(lds, cc, tid, rk, rv);
        const AChunk cur = cc; const AStep cst = st;
        if (st.ch < 2) { ++st.ch; } else { ++round; st.unit = unit_of(round); st.ch = st.unit < 2048 ? 0 : 2; st.valid = (round < 8) || (round == 8 && l == 0); }
        if (st.valid) { at_chunk(st, cc); at_load(a, cc, tid, rk, rv); }
        const bool latent = cst.unit < 2048;
        if (cst.ch == 0 || !latent) {
            if (latent) { const int rp = cst.unit & 15; w.r = 2 * rp + (wid >> 2); w.mt = wid & 3; w.qrow0 = cur.b * 2048 + w.r * 64 + w.mt * 16; }
            else { w.r = 0; w.mt = ((cst.unit - 2048) & 1) * 8 + wid; w.qrow0 = TLAT + cur.b * 256 + w.mt * 16; }
            w.rs = min(max(w.r - 4, 0), 24); w.cb = min(max(w.mt * 16 - 8, 0), 32);
#pragma unroll
            for (int kd = 0; kd < 2; ++kd) w.qf[kd] = *(const bf16x8*)(Qb + (size_t)(w.qrow0 + fr) * 512 + cur.h * 64 + kd * 32 + fq * 8);
#pragma unroll
            for (int i = 0; i < 4; ++i) w.o[i] = (f32x4){0.f, 0.f, 0.f, 0.f};
            w.mrun = -1e30f; w.lrun = 0.f;
        }
        __syncthreads();
        if (!cur.isctx) {
            const int qc = w.mt * 16 + fr, cs = min(max(qc - 8, 0), 48);
            const float* rp_ = a.in[11] + ((size_t)l * 8 + cur.h) * 15 * 31;
            f32x4 s[5][2]; u32x4 pk[5]; float mx = -1e30f;
#pragma unroll
            for (int bi = 0; bi < 5; ++bi) {
                const int keyrow = cur.R_lo + cur.c0 + bi;
                if (bi < cur.nr && keyrow >= w.rs && keyrow <= w.rs + 7) at_scores<true>(lds, w, bi * 64 + 4 * (w.cb >> 3), fr, fq, rp_ + (keyrow - w.r + 7) * 31, cs, qc, s[bi], mx);
                else { s[bi][0] = s[bi][1] = (f32x4){-1e30f, -1e30f, -1e30f, -1e30f}; }
            }
            at_flash<5>(w, s, mx, pk);
#pragma unroll
            for (int bi = 0; bi < 5; ++bi) {
                const int keyrow = cur.R_lo + cur.c0 + bi;
                if (bi < cur.nr && keyrow >= w.rs && keyrow <= w.rs + 7) at_pv(lds, w, pk[bi], bi * 64 + w.cb, fr, fq);
            }
        } else {
            f32x4 s[8][2]; u32x4 pk[8]; float mx = -1e30f;
#pragma unroll
            for (int bi = 0; bi < 8; ++bi) at_scores<false>(lds, w, (bi >> 1) * 64 + 16 * (bi & 1), fr, fq, nullptr, 0, 0, s[bi], mx);
            at_flash<8>(w, s, mx, pk);
#pragma unroll
            for (int bi = 0; bi < 8; ++bi) at_pv(lds, w, pk[bi], bi * 32, fr, fq);
            const float inv = 1.0f / w.lrun;
#pragma unroll
            for (int i = 0; i < 4; ++i) { u32x2 ov; ov.x = cvt_pk_bf16(w.o[i][0] * inv, w.o[i][1] * inv); ov.y = cvt_pk_bf16(w.o[i][2] * inv, w.o[i][3] * inv);
                *(u32x2*)(mix + (size_t)(w.qrow0 + fr) * 1024 + cur.h * 64 + i * 16 + fq * 4) = ov; }
        }
    }
    __syncthreads();
}

__device__ void phase_mixers(const Args& a, unsigned char* lds, int l) {
    const int G = gridDim.x;
#ifndef REP_S5
#define REP_S5 1
#endif
#ifndef REP_DFT
#define REP_DFT 1
#endif
#ifndef REP_ATT
#define REP_ATT 1
#endif
#ifndef NO_S5
    for (int rep = 0; rep < REP_S5; ++rep)
    for (int u = blockIdx.x; u < 256; u += G) { s5_unit(a, lds, l, u); __syncthreads(); }
#endif
#ifndef NO_DFT
    const int nd = 256 + (l == 0 ? 32 : 0);
    for (int rep = 0; rep < REP_DFT; ++rep)
    for (int u = blockIdx.x; u < nd; u += G) {
        if (u < 256) { const int b = u >> 4, tm = (u >> 1) & 7, tn = u & 1;
            const AlRow al{(const bf16_t*)(a.ws + WS_DFTL) + (size_t)tm * 256 * 4096, 4096};
            const BlDft bl{(const bf16_t*)(a.ws + WS_GTL) + (size_t)b * 512 * 2048, 2048, tn * 128};
            const EpPlain ep{(bf16_t*)(a.ws + WS_MIX), 1024, b * 2048 + tm * 256, 768 + tn * 128};
            gemm_tile<256, 128, 4, 2, true>(lds, 4096, al, bl, ep);
        } else { const int v = u - 256, b = v >> 1, tn = v & 1;
            const AlRow al{(const bf16_t*)(a.ws + WS_DFTC), 512};
            const BlDft bl{(const bf16_t*)(a.ws + WS_GTC) + (size_t)b * 512 * 256, 256, tn * 128};
            const EpPlain ep{(bf16_t*)(a.ws + WS_MIX), 1024, TLAT + b * 256, 768 + tn * 128};
            gemm_tile<256, 128, 4, 2, true>(lds, 512, al, bl, ep);
        }
    }
#endif
#ifndef NO_ATT
    for (int rep = 0; rep < REP_ATT; ++rep) attn_phase(a, lds, l);
#endif
}

struct EpGlu2 { const bf16_t* yb; bf16_t* mix; const float* bg; int m0;
    __device__ __forceinline__ void operator()(Acc256& acc, int wr, int wc, int fr, int fq) const {
#pragma unroll
        for (int ai = 0; ai < 2; ++ai)
#pragma unroll
            for (int m = 0; m < 4; ++m)
#pragma unroll
                for (int bj = 0; bj < 2; ++bj)
#pragma unroll
                    for (int n = 0; n < 2; ++n) {
                        const int row = m0 + ai * 128 + wr * 64 + m * 16 + fr, col = wc * 64 + bj * 32 + n * 16 + fq * 4;
                        const u32x2 gw = *(const u32x2*)(yb + (size_t)row * 256 + col); const f32x4 bv = *(const f32x4*)(bg + col);
                        const float g0 = __uint_as_float(gw.x << 16), g1 = __uint_as_float(gw.x & 0xffff0000u), g2 = __uint_as_float(gw.y << 16), g3 = __uint_as_float(gw.y & 0xffff0000u);
                        u32x2 w; w.x = cvt_pk_bf16(g0 * sigmoidf_(acc[ai][bj][m][n][0] + bv[0]), g1 * sigmoidf_(acc[ai][bj][m][n][1] + bv[1]));
                        w.y = cvt_pk_bf16(g2 * sigmoidf_(acc[ai][bj][m][n][2] + bv[2]), g3 * sigmoidf_(acc[ai][bj][m][n][3] + bv[3]));
                        *(u32x2*)(mix + (size_t)row * 1024 + 512 + col) = w;
                    }
    } };
__device__ void phase_glu(const Args& a, LAS unsigned char* lds, int l, int M) {
    for (int u = blockIdx.x; u < M / 256; u += gridDim.x) {
        const int m0 = u * 256;
        unsigned voA[2][2], voB[2][2];
        make_offsets(voA, voB, [&](int r) { return (unsigned)(WS_YB + (size_t)(m0 + r) * 512); }, [&](int c) { return (unsigned)(WS_WGLU + ((size_t)l * 256 + c) * 512); });
        const EpGlu2 ep{(const bf16_t*)(a.ws + WS_YB), (bf16_t*)(a.ws + WS_MIX), a.in[21] + l * 256, m0};
        gemm256<true>(lds, a.ws, voA, voB, 4, KLin(), KLin(), ep);
    }
}

struct EpRes2 { const Args* a; const float* mod2; int l, m0, n0;
    __device__ __forceinline__ void operator()(Acc256& acc, int wr, int wc, int fr, int fq) const {
#pragma unroll
        for (int ai = 0; ai < 2; ++ai)
#pragma unroll
            for (int m = 0; m < 4; ++m) {
                const int row = m0 + ai * 128 + wr * 64 + m * 16 + fr;
                const float* xi = (l == 0) ? input_row(*a, row) : stream_row(*a, row);
                float* xo = stream_row(*a, row);
                const float* mr = mod2 + (size_t)row_batch(row) * 6144;
#pragma unroll
                for (int bj = 0; bj < 2; ++bj)
#pragma unroll
                    for (int n = 0; n < 2; ++n) { const int col = n0 + wc * 64 + bj * 32 + n * 16 + fq * 4;
                        const f32x4 xv = *(const f32x4*)(xi + col), gv = *(const f32x4*)(mr + col);
                        *(f32x4*)(xo + col) = xv + gv * acc[ai][bj][m][n]; }
            }
    } };
__device__ void phase_wout(const Args& a, LAS unsigned char* lds, int l, int M) {
    const float* mod2 = (const float*)(a.ws + WS_MOD) + (size_t)l * 17 * 6144 + 2 * 1024;
    for (int u = blockIdx.x; u < (M / 256) * 4; u += gridDim.x) {
        const int m0 = (u >> 2) * 256, n0 = (u & 3) * 256;
        unsigned voA[2][2], voB[2][2];
        make_offsets(voA, voB, [&](int r) { return (unsigned)(WS_MIX + (size_t)(m0 + r) * 2048); }, [&](int c) { return (unsigned)(WS_WOUT + ((size_t)l * 1024 + n0 + c) * 2048); });
        const EpRes2 ep{&a, mod2, l, m0, n0};
        gemm256<true>(lds, a.ws, voA, voB, 16, KLin(), KLin(), ep);
    }
}

__device__ __forceinline__ int pair_id(int lo, int hi) { return lo == 0 ? hi - 1 : (lo == 1 ? hi + 1 : 5); }
__device__ void phase_norm2(const Args& a, unsigned char* lds, int l, int M) {
    const int tid = otid(), lane = tid & 63, wid = tid >> 6;
    float* wr = (float*)lds;
    int* rcls = (int*)(wr + 16 * 1024);
    float2* rw = (float2*)(rcls + 160);
    int* rrank = (int*)(rw + 160);
    int* cbase = rrank + 160;
    int* ccnt = cbase + 32;
    for (int i = tid; i < 16 * 1024; i += NTHR) { const int e = i >> 10, k = i & 1023; wr[i] = a.in[24][k * 16 + e]; }
    __syncthreads();
    const int rpb_ = M / gridDim.x;
    const int row0 = blockIdx.x * rpb_;
    const float* g2 = a.in[7] + l * 1024;
    const float* mod = (const float*)(a.ws + WS_MOD) + (size_t)l * 17 * 6144;
    bf16_t* hb = (bf16_t*)(a.ws + WS_HBUF);
    float br[16];
#pragma unroll
    for (int e = 0; e < 16; ++e) br[e] = a.in[25][e];
    for (int lr = wid; lr < rpb_; lr += 8) {
        const int m = row0 + lr;
        const float* xr = stream_row(a, m);
        const float* mr = mod + (size_t)row_batch(m) * 6144;
        f32x4 v[4]; float ss = 0.f;
#pragma unroll
        for (int i = 0; i < 4; ++i) { v[i] = *(const f32x4*)(xr + i * 256 + lane * 4); ss += v[i][0] * v[i][0] + v[i][1] * v[i][1] + v[i][2] * v[i][2] + v[i][3] * v[i][3]; }
        ss = wave_sum(ss);
        const float rstd = rsqrtf(ss * (1.0f / 1024.0f) + 1e-6f);
        float lg[16];
#pragma unroll
        for (int e = 0; e < 16; ++e) lg[e] = 0.f;
#pragma unroll
        for (int i = 0; i < 4; ++i) {
            const int c = i * 256 + lane * 4;
            const f32x4 g = *(const f32x4*)(g2 + c), sh = *(const f32x4*)(mr + 3 * 1024 + c), sc = *(const f32x4*)(mr + 4 * 1024 + c);
            f32x4 o;
#pragma unroll
            for (int j = 0; j < 4; ++j) o[j] = v[i][j] * rstd * g[j] * (1.0f + sc[j]) + sh[j];
            u32x2 w; w.x = cvt_pk_bf16(o[0], o[1]); w.y = cvt_pk_bf16(o[2], o[3]);
            *(u32x2*)(hb + (size_t)m * 1024 + c) = w;
#pragma unroll
            for (int e = 0; e < 16; ++e) { const f32x4 wv = *(const f32x4*)(wr + e * 1024 + c); lg[e] += o[0] * wv[0] + o[1] * wv[1] + o[2] * wv[2] + o[3] * wv[3]; }
        }
#pragma unroll
        for (int e = 0; e < 16; ++e) lg[e] = wave_sum(lg[e]);
        float aff[16], sel[16];
#pragma unroll
        for (int e = 0; e < 16; ++e) { aff[e] = sigmoidf_(lg[e]); sel[e] = aff[e] + br[e]; }
        int bg = 0, blo = 0, bhi = 1; float bscore = -1e30f, bwlo = 0.f, bwhi = 0.f;
#pragma unroll
        for (int g = 0; g < 4; ++g) {
            int i1 = 0; float v1 = sel[g * 4];
#pragma unroll
            for (int j = 1; j < 4; ++j) if (sel[g * 4 + j] > v1) { v1 = sel[g * 4 + j]; i1 = j; }
            int i2 = -1; float v2 = -1e30f;
#pragma unroll
            for (int j = 0; j < 4; ++j) if (j != i1 && sel[g * 4 + j] > v2) { v2 = sel[g * 4 + j]; i2 = j; }
            const float sc = v1 + v2;
            if (sc > bscore) { bscore = sc; bg = g; blo = min(i1, i2); bhi = max(i1, i2);
                float a1 = 0.f, a2 = 0.f;
#pragma unroll
                for (int j = 0; j < 4; ++j) { if (j == blo) a1 = aff[g * 4 + j]; if (j == bhi) a2 = aff[g * 4 + j]; }
                bwlo = a1 / (a1 + a2); bwhi = a2 / (a1 + a2); }
        }
        if (lane == 0) { rcls[lr] = bg * 6 + pair_id(blo, bhi); rw[lr] = make_float2(bwlo, bwhi); }
    }
    __syncthreads();
    if (tid < NCLS) { int n = 0; for (int i = 0; i < rpb_; ++i) if (rcls[i] == tid) { rrank[i] = n; ++n; } ccnt[tid] = n;
        cbase[tid] = n > 0 ? (int)atomicAdd((unsigned*)(a.ws + WS_CTL) + 4096 + l * 32 + tid, (unsigned)n) : 0; }
    __syncthreads();
    int* perm = (int*)(a.ws + WS_PERM); float2* tokw = (float2*)(a.ws + WS_TOKW);
    for (int i = tid; i < rpb_; i += NTHR) { const int c = rcls[i]; perm[(size_t)c * TT + cbase[c] + rrank[i]] = row0 + i; tokw[row0 + i] = rw[i]; }
    __syncthreads();
}

struct MoeTiles { int tile0[NCLS + 1]; int cnt[NCLS]; };
__device__ __forceinline__ void moe_tiles(const Args& a, int l, int* sh  ) {
    if (otid() == 0) { int t = 0; for (int c = 0; c < NCLS; ++c) { const int n = (int)__hip_atomic_load((unsigned*)(a.ws + WS_CTL) + 4096 + l * 32 + c, __ATOMIC_RELAXED, __HIP_MEMORY_SCOPE_AGENT); sh[c] = t; sh[32 + c] = n; t += (n + 255) >> 8; } sh[NCLS] = t; }
    __syncthreads();
}
__device__ __forceinline__ void class_experts(int c, int& e_lo, int& e_hi) { const int g = c / 6, p = c % 6; const int lo = p < 3 ? 0 : (p < 5 ? 1 : 2); const int hi = p < 3 ? p + 1 : (p < 5 ? p - 1 : 3); e_lo = g * 4 + lo; e_hi = g * 4 + hi; }

struct EpGateUp2 { bf16_t* hm; const int* perm; const float2* tokw; int cnt, r0, rowbase, slot, hc0;
    __device__ __forceinline__ void operator()(Acc256& acc, int wr, int wc, int fr, int fq) const {
#pragma unroll
        for (int ai = 0; ai < 2; ++ai)
#pragma unroll
            for (int m = 0; m < 4; ++m) {
                const int r = r0 + ai * 128 + wr * 64 + m * 16 + fr;
                if (r < cnt) {
                    const float2 w2 = tokw[perm[r]]; const float w = slot == 0 ? w2.x : w2.y;
#pragma unroll
                    for (int n = 0; n < 2; ++n) {
                        float hv[4];
#pragma unroll
                        for (int j = 0; j < 4; ++j) hv[j] = siluf_(acc[ai][0][m][n][j]) * acc[ai][1][m][n][j] * w;
                        u32x2 o; o.x = cvt_pk_bf16(hv[0], hv[1]); o.y = cvt_pk_bf16(hv[2], hv[3]);
                        *(u32x2*)(hm + (size_t)(rowbase + r) * 1024 + slot * 512 + hc0 + wc * 32 + n * 16 + fq * 4) = o;
                    }
                }
            }
    } };
__device__ void phase_moe_up(const Args& a, LAS unsigned char* lds, int l) {
    int* sh = (int*)((unsigned char*)lds + 128 * 1024);
    moe_tiles(a, l, sh);
    const int ntile = sh[NCLS];
    for (int u = blockIdx.x; u < ntile * 8; u += gridDim.x) {
        const int tile = u >> 3, nt = u & 7;
        int c = 0; while (c + 1 < NCLS && sh[c + 1] <= tile) ++c;
        const int cnt = sh[32 + c], r0 = (tile - sh[c]) * 256, rowbase = sh[c] * 256;
        int e_lo, e_hi; class_experts(c, e_lo, e_hi);
        const int slot = nt >> 2, hc0 = (nt & 3) * 128, e = slot == 0 ? e_lo : e_hi;
        const int* perm = (const int*)(a.ws + WS_PERM) + (size_t)c * TT;
        unsigned voA[2][2], voB[2][2];
        make_offsets(voA, voB, [&](int r) { return (unsigned)(WS_HBUF + (size_t)perm[min(r0 + r, cnt - 1)] * 2048); },
                     [&](int cc) { const int w = cc & 63; return (unsigned)((w < 32 ? WS_WG : WS_WU) + (((size_t)l * 16 + e) * 512 + hc0 + (cc >> 6) * 32 + (w & 31)) * 2048); });
        const EpGateUp2 ep{(bf16_t*)(a.ws + WS_HMOE), perm, (const float2*)(a.ws + WS_TOKW), cnt, r0, rowbase, slot, hc0};
        gemm256<true>(lds, a.ws, voA, voB, 16, KLin(), KLin(), ep);
    }
}
struct KDown { unsigned d1; __device__ __forceinline__ unsigned operator()(int kt) const { return kt < 8 ? (unsigned)kt * 128u : d1 + (unsigned)(kt - 8) * 128u; } };
struct EpDown2 { const Args* a; const int* perm; const float* mod5; int cnt, r0, n0;
    __device__ __forceinline__ void operator()(Acc256& acc, int wr, int wc, int fr, int fq) const {
#pragma unroll
        for (int ai = 0; ai < 2; ++ai)
#pragma unroll
            for (int m = 0; m < 4; ++m) {
                const int r = r0 + ai * 128 + wr * 64 + m * 16 + fr;
                if (r < cnt) {
                    const int row = perm[r];
                    float* xo = stream_row(*a, row);
                    const float* mr = mod5 + (size_t)row_batch(row) * 6144;
#pragma unroll
                    for (int bj = 0; bj < 2; ++bj)
#pragma unroll
                        for (int n = 0; n < 2; ++n) { const int col = n0 + wc * 64 + bj * 32 + n * 16 + fq * 4;
                            const f32x4 xv = *(const f32x4*)(xo + col), gv = *(const f32x4*)(mr + col);
                            *(f32x4*)(xo + col) = xv + gv * acc[ai][bj][m][n]; }
                }
            }
    } };
__device__ void phase_moe_down(const Args& a, LAS unsigned char* lds, int l) {
    int* sh = (int*)((unsigned char*)lds + 128 * 1024);
    moe_tiles(a, l, sh);
    const int ntile = sh[NCLS];
    const float* mod5 = (const float*)(a.ws + WS_MOD) + (size_t)l * 17 * 6144 + 5 * 1024;
    for (int u = blockIdx.x; u < ntile * 4; u += gridDim.x) {
        const int tile = u >> 2, nt = u & 3;
        int c = 0; while (c + 1 < NCLS && sh[c + 1] <= tile) ++c;
        const int cnt = sh[32 + c], r0 = (tile - sh[c]) * 256, rowbase = sh[c] * 256;
        int e_lo, e_hi; class_experts(c, e_lo, e_hi);
        unsigned voA[2][2], voB[2][2];
        make_offsets(voA, voB, [&](int r) { return (unsigned)(WS_HMOE + (size_t)(rowbase + r0 + r) * 2048); },
                     [&](int cc) { return (unsigned)(WS_WD + (((size_t)l * 16 + e_lo) * 1024 + nt * 256 + cc) * 1024); });
        const EpDown2 ep{&a, (const int*)(a.ws + WS_PERM) + (size_t)c * TT, mod5, cnt, r0, nt * 256};
        gemm256<true>(lds, a.ws, voA, voB, 16, KLin(), KDown{(unsigned)(e_hi - e_lo) * 1024u * 1024u}, ep);
    }
}

constexpr int LDS_BYTES = 129 * 1024;
constexpr int NPHASE = 17;
#ifndef PHSEL
#define PHSEL 0x1ff
#endif
#ifndef DUPSEL
#define DUPSEL 0
#endif
#define PHASE(kind, idx, body) do { if (((PHSEL >> (kind)) & 1) && a.ph_lo <= (idx) && (idx) < a.ph_hi) { body; if ((DUPSEL >> (kind)) & 1) { __syncthreads(); body; } } if (a.ph_lo <= (idx) && (idx) + 1 < a.ph_hi) xcd_barrier(bar); } while (0)

__global__ void __launch_bounds__(NTHR, 2) fwd(Args a) {
    extern __shared__ __attribute__((aligned(16))) unsigned char smem[];
    unsigned char* lds = smem + 16;
    LAS unsigned char* ldsl = (LAS unsigned char*)lds;
    if (threadIdx.x == 0) *(uint4*)smem = make_uint4(0u, 0u, 0u, 0u);
    __syncthreads();
    XcdBarrier bar = xcd_barrier_post((unsigned*)(a.ws + WS_CTL), (volatile LAS unsigned*)smem);
    PHASE(0, 0, phase_prologue(a, lds));
    for (int l = 0; l < 2; ++l) {
        const int M = l == 0 ? TT : TLAT;
        const int p = 1 + 8 * l;
        PHASE(1, p + 0, phase_norm1(a, l));
        PHASE(2, p + 1, phase_win(a, ldsl, l));
        PHASE(3, p + 2, phase_mixers(a, lds, l));
        PHASE(4, p + 3, phase_glu(a, ldsl, l, M));
        PHASE(5, p + 4, phase_wout(a, ldsl, l, M));
        PHASE(6, p + 5, phase_norm2(a, lds, l, M));
        PHASE(7, p + 6, phase_moe_up(a, ldsl, l));
        PHASE(8, p + 7, phase_moe_down(a, ldsl, l));
    }
}

#ifndef N_LAUNCHES
#define N_LAUNCHES 1
#endif

extern "C" void kernel_launch(void* const* d_in, const int* in_sizes, int n_in, void* d_out, int out_size, void* d_ws, size_t ws_size, hipStream_t stream) {
    static int grid = 0;
    if (grid == 0) {
        if (n_in != 29 || out_size != TLAT * DM || ws_size < WS_END) { fprintf(stderr, "kernel_launch: unexpected shapes (n_in %d out %d ws %zu need %zu)\n", n_in, out_size, ws_size, (size_t)WS_END); grid = -1; return; }
        int dev = 0, cus = 0, per_cu = 0;
        if (hipGetDevice(&dev) != hipSuccess || hipDeviceGetAttribute(&cus, hipDeviceAttributeMultiprocessorCount, dev) != hipSuccess) { grid = -1; return; }
        if (hipFuncSetAttribute((const void*)fwd, hipFuncAttributeMaxDynamicSharedMemorySize, LDS_BYTES + 16) != hipSuccess) { fprintf(stderr, "kernel_launch: hipFuncSetAttribute failed\n"); grid = -1; return; }
        if (hipOccupancyMaxActiveBlocksPerMultiprocessor(&per_cu, (const void*)fwd, NTHR, LDS_BYTES + 16) != hipSuccess || per_cu < 1) fprintf(stderr, "kernel_launch: occupancy query says %d\n", per_cu);
        (void)hipGetLastError();
        grid = cus;
        if (grid != 256) { fprintf(stderr, "kernel_launch: built for 256 CUs, device has %d\n", cus); if (grid > 256 || TT % grid || TLAT % grid) { grid = -1; return; } }
    }
    if (grid < 0) return;
    (void)hipMemsetAsync((char*)d_ws + WS_CTL, 0, CTL_BYTES, stream);
    Args a{};
    for (int i = 0; i < 29; ++i) a.in[i] = (const float*)d_in[i];
    a.out = (float*)d_out; a.ws = (unsigned char*)d_ws;
    if (N_LAUNCHES == 1) { a.ph_lo = 0; a.ph_hi = NPHASE; hipLaunchKernelGGL(fwd, dim3(grid), dim3(NTHR), LDS_BYTES + 16, stream, a); }
    else for (int i = 0; i < NPHASE; ++i) { a.ph_lo = i; a.ph_hi = i + 1; hipLaunchKernelGGL(fwd, dim3(grid), dim3(NTHR), LDS_BYTES + 16, stream, a); }
}
```
